# Optimizing an MI355X kernel written in HIP

```python
import math
import jax, jax.numpy as jnp
from jax import lax
import numpy as np

D_MODEL = 2048
BATCH = 4
SEQ = 2048
DEPTH = 4
DEC_BATCH = 128
DEC_SEQ = 1
PAST_LEN = 16384
PAGE_SIZE = 128

N_AB = (DEPTH + 1) // 2
N_C = DEPTH // 2
D_A = D_MODEL // 2
GS_A = 16
G_A = D_A // GS_A
N_A = 64
D_B = D_MODEL // 2
K_B = 128
H_B = D_B // K_B
V_B = D_B // H_B
D_IN_AB = D_A + 4 * D_B
CHUNK_B = 64
D_RNN = (D_MODEL * 4 // 3) // 256 * 256
NB_C = 16
BS_C = D_RNN // NB_C
CONV_W = 4
LRU_C = 8.0
D_FF = (D_MODEL * 8 // 3) // 128 * 128
N_MOD = 9
EPS = 1e-6

kernel_name = "hybrid_s5_hgrn2_rglru_decode_step"


def rmsnorm(x, w):
    xf = x.astype(jnp.float32)
    y = xf * lax.rsqrt(jnp.mean(xf * xf, axis=-1, keepdims=True) + EPS)
    return (y * w.astype(jnp.float32)).astype(x.dtype)


def modulate(h, shift, scale):
    return h * (1.0 + scale) + shift


def swiglu(h, w_gu, w_d):
    gate, up = jnp.split(h @ w_gu, 2, axis=-1)
    return (jax.nn.silu(gate) * up) @ w_d


def cmul(ar, ai, br, bi):
    return ar * br - ai * bi, ar * bi + ai * br


def complex_linear_scan(ar, ai, br, bi):
    def combine(e1, e2):
        a1r, a1i, b1r, b1i = e1
        a2r, a2i, b2r, b2i = e2
        nar, nai = cmul(a2r, a2i, a1r, a1i)
        tr, ti = cmul(a2r, a2i, b1r, b1i)
        return nar, nai, tr + b2r, ti + b2i
    return lax.associative_scan(combine, (ar, ai, br, bi), axis=1)


def real_linear_scan(a, b):
    def combine(e1, e2):
        a1, b1 = e1
        a2, b2 = e2
        return a1 * a2, a2 * b1 + b2
    return lax.associative_scan(combine, (a, b), axis=1)[1]


def s5_mixer(u, h0_re, h0_im, lam_re, lam_im, b_re, b_im, c_re, c_im, d_skip, log_step, w_glu, b_glu):
    f32 = jnp.float32
    Bsz, L, _ = u.shape
    uf = u.astype(f32).reshape(Bsz, L, G_A, GS_A)
    step = jnp.exp(log_step.astype(f32))[:, None]
    lr, li = lam_re.astype(f32), lam_im.astype(f32)
    mag = jnp.exp(lr * step)
    abar_r, abar_i = mag * jnp.cos(li * step), mag * jnp.sin(li * step)
    den = lr * lr + li * li
    pr, pim = abar_r - 1.0, abar_i
    zr = (pr * lr + pim * li) / den
    zi = (pim * lr - pr * li) / den
    bbr, bbi = cmul(zr[..., None], zi[..., None], b_re.astype(f32), b_im.astype(f32))
    xr = jnp.einsum("blgk,gnk->blgn", uf, bbr)
    xi = jnp.einsum("blgk,gnk->blgn", uf, bbi)
    ir, ii = cmul(abar_r, abar_i, h0_re.astype(f32), h0_im.astype(f32))
    xr = xr.at[:, 0].add(ir)
    xi = xi.at[:, 0].add(ii)
    ar = jnp.broadcast_to(abar_r, xr.shape)
    ai = jnp.broadcast_to(abar_i, xr.shape)
    _, _, hr, hi = complex_linear_scan(ar, ai, xr, xi)
    y = (jnp.einsum("blgn,gkn->blgk", hr, c_re.astype(f32))
         - jnp.einsum("blgn,gkn->blgk", hi, c_im.astype(f32)))
    y = y.reshape(Bsz, L, D_A) + d_skip.astype(f32) * u.astype(f32)
    y = jax.nn.gelu(y).astype(u.dtype)
    out = y * jax.nn.sigmoid(y @ w_glu + b_glu)
    return out, hr[:, -1].astype(h0_re.dtype), hi[:, -1].astype(h0_im.dtype)


def hgrn2_mixer(q, fz, iv, g, s0, lb, gnorm_w):
    f32 = jnp.float32
    Bsz, L, _ = q.shape
    lbf = lb.astype(f32)
    log_f = jnp.logaddexp(jnp.log(lbf), jnp.log1p(-lbf) + jax.nn.log_sigmoid(fz.astype(f32)))
    k = -jnp.expm1(log_f)
    C = min(CHUNK_B, L)
    n_chunks = -(-L // C)
    pad = n_chunks * C - L

    def to_chunks(t):
        t = jnp.pad(t.astype(f32), ((0, 0), (0, pad), (0, 0)))
        return t.reshape(Bsz, n_chunks, C, H_B, -1).transpose(1, 0, 3, 2, 4)

    qc, kc, vc, gc = to_chunks(q), to_chunks(k), to_chunks(iv), to_chunks(log_f)
    causal = jnp.tril(jnp.ones((C, C), dtype=bool))[:, :, None]

    def chunk_step(S, inp):
        qb, kb, vb, lfb = inp
        G = jnp.cumsum(lfb, axis=2)
        diff = G[:, :, :, None, :] - G[:, :, None, :, :]
        decay = jnp.exp(jnp.where(causal, diff, -jnp.inf))
        scores = jnp.einsum("bhtk,bhsk,bhtsk->bhts", qb, kb, decay)
        o = (jnp.einsum("bhts,bhsv->bhtv", scores, vb)
             + jnp.einsum("bhtk,bhkv->bhtv", qb * jnp.exp(G), S))
        G_last = G[:, :, -1:, :]
        S_new = (jnp.exp(G_last[:, :, 0, :, None]) * S
                 + jnp.einsum("bhsk,bhsv->bhkv", kb * jnp.exp(G_last - G), vb))
        return S_new, o

    S_fin, o = lax.scan(chunk_step, s0.astype(f32), (qc, kc, vc, gc))
    o = o.transpose(1, 0, 3, 2, 4).reshape(Bsz, n_chunks * C, H_B, V_B)[:, :L]
    o = o * lax.rsqrt(jnp.mean(o * o, axis=-1, keepdims=True) + EPS) * gnorm_w.astype(f32)
    o = o * jax.nn.silu(g.astype(f32).reshape(Bsz, L, H_B, V_B))
    return o.reshape(Bsz, L, D_B).astype(q.dtype), S_fin.astype(s0.dtype)


def block_diag(x, w, b):
    xb = x.reshape(x.shape[0], x.shape[1], NB_C, BS_C)
    return jnp.einsum("blnj,njk->blnk", xb, w).reshape(x.shape) + b


def rglru_block(h, conv_buf, h0, w_in_c, conv_w, conv_b, w_ga, b_ga, w_gx, b_gx, lru_lambda, w_out_c):
    f32 = jnp.float32
    gate_br, xr = jnp.split(h @ w_in_c, 2, axis=-1)
    L = xr.shape[1]
    xp = jnp.concatenate([conv_buf.astype(xr.dtype), xr], axis=1)
    xc = conv_b + xp[:, 0:L] * conv_w[0]
    for j in range(1, CONV_W):
        xc = xc + xp[:, j:j + L] * conv_w[j]
    new_buf = xp[:, L:]
    r = jax.nn.sigmoid(block_diag(xc, w_ga, b_ga).astype(f32))
    ig = jax.nn.sigmoid(block_diag(xc, w_gx, b_gx).astype(f32))
    log_a = LRU_C * r * jax.nn.log_sigmoid(lru_lambda.astype(f32))
    a = jnp.exp(log_a)
    bterm = jnp.sqrt(-jnp.expm1(2.0 * log_a)) * ig * xc.astype(f32)
    bterm = bterm.at[:, 0].add(a[:, 0] * h0.astype(f32))
    hs = real_linear_scan(a, bterm)
    y = (jax.nn.gelu(gate_br.astype(f32)) * hs).astype(h.dtype) @ w_out_c
    return y, new_buf.astype(conv_buf.dtype), hs[:, -1].astype(h0.dtype)


def run_group(x, c, s5_re0, s5_im0, hgrn0, lru0, conv0, P):
    Bsz = x.shape[0]
    lb_all = jnp.cumsum(jax.nn.softmax(P["hg_lb_logits"].astype(jnp.float32), axis=0), axis=0)
    lb_all = lb_all - lb_all[0:1]
    sc = jax.nn.silu(c)
    s5r_l, s5i_l, hg_l, lru_l, conv_l = [], [], [], [], []
    for l in range(DEPTH):
        j = l // 2
        m = (sc @ P["w_ada"][l] + P["b_ada"][l]).reshape(Bsz, N_MOD, 1, D_MODEL)
        h = modulate(rmsnorm(x, P["norm_w"][l, 0]), m[:, 0], m[:, 1])
        x = x + 0.5 * m[:, 2] * swiglu(h, P["w_ffn_gu"][l, 0], P["w_ffn_d"][l, 0])
        h = modulate(rmsnorm(x, P["norm_w"][l, 1]), m[:, 3], m[:, 4])
        if l % 2 == 0:
            z = h @ P["w_in_ab"][j]
            u, q, fz, iv, g = jnp.split(z, [D_A, D_A + D_B, D_A + 2 * D_B, D_A + 3 * D_B], axis=-1)
            ya, s5r, s5i = s5_mixer(u, s5_re0[j], s5_im0[j], P["s5_lam_re"][j], P["s5_lam_im"][j],
                                    P["s5_b_re"][j], P["s5_b_im"][j], P["s5_c_re"][j], P["s5_c_im"][j],
                                    P["s5_d"][j], P["s5_log_step"][j], P["s5_w_glu"][j], P["s5_b_glu"][j])
            yb, hgS = hgrn2_mixer(q, fz, iv, g, hgrn0[j], lb_all[j], P["hg_norm_w"][j])
            mix = jnp.concatenate([ya, yb], axis=-1) @ P["w_out_ab"][j]
            s5r_l.append(s5r)
            s5i_l.append(s5i)
            hg_l.append(hgS)
        else:
            mix, cb, hl = rglru_block(h, conv0[j], lru0[j], P["w_in_c"][j], P["conv_w"][j], P["conv_b"][j],
                                      P["w_gate_a"][j], P["b_gate_a"][j], P["w_gate_x"][j], P["b_gate_x"][j],
                                      P["lru_lambda"][j], P["w_out_c"][j])
            conv_l.append(cb)
            lru_l.append(hl)
        x = x + m[:, 5] * mix
        h = modulate(rmsnorm(x, P["norm_w"][l, 2]), m[:, 6], m[:, 7])
        x = x + 0.5 * m[:, 8] * swiglu(h, P["w_ffn_gu"][l, 1], P["w_ffn_d"][l, 1])
    y = rmsnorm(x, P["final_norm_w"])
    return y, jnp.stack(s5r_l), jnp.stack(s5i_l), jnp.stack(hg_l), jnp.stack(lru_l), jnp.stack(conv_l)


def setup_inputs(seed: int = 0) -> dict:
    key = jax.random.key(seed)
    ks = iter(jax.random.split(key, 64))
    f32 = jnp.float32

    def nrm(shape, scale):
        return jax.random.normal(next(ks), shape, f32) * scale

    n_idx = jnp.arange(N_A, dtype=f32)
    a0 = jax.random.uniform(next(ks), (N_C, D_RNN), f32, 0.9, 0.999)
    p = a0 ** (1.0 / LRU_C)
    return {
        "x_prompt": nrm((BATCH, SEQ, D_MODEL), 1.0),
        "x_sample": nrm((DEC_BATCH, DEC_SEQ, D_MODEL), 1.0),
        "state_s5_re": nrm((N_AB, DEC_BATCH, G_A, N_A), 0.1),
        "state_s5_im": nrm((N_AB, DEC_BATCH, G_A, N_A), 0.1),
        "state_hgrn": nrm((N_AB, DEC_BATCH, H_B, K_B, V_B), 0.5),
        "state_lru": nrm((N_C, DEC_BATCH, D_RNN), 0.5),
        "state_conv": nrm((N_C, DEC_BATCH, CONV_W - 1, D_RNN), 1.0),
        "c_prompt": nrm((BATCH, D_MODEL), 1.0),
        "c_sample": nrm((DEC_BATCH, D_MODEL), 1.0),
        "norm_w": 1.0 + nrm((DEPTH, 3, D_MODEL), 0.02),
        "final_norm_w": 1.0 + nrm((D_MODEL,), 0.02),
        "w_ada": nrm((DEPTH, D_MODEL, N_MOD * D_MODEL), 0.5 * D_MODEL ** -0.5),
        "b_ada": nrm((DEPTH, N_MOD * D_MODEL), 0.02),
        "w_ffn_gu": nrm((DEPTH, 2, D_MODEL, 2 * D_FF), D_MODEL ** -0.5),
        "w_ffn_d": nrm((DEPTH, 2, D_FF, D_MODEL), D_FF ** -0.5),
        "w_in_ab": nrm((N_AB, D_MODEL, D_IN_AB), D_MODEL ** -0.5),
        "s5_lam_re": -0.5 * (1.0 + nrm((N_AB, G_A, N_A), 0.01)),
        "s5_lam_im": math.pi * n_idx + nrm((N_AB, G_A, N_A), 0.01),
        "s5_b_re": nrm((N_AB, G_A, N_A, GS_A), (2 * GS_A) ** -0.5),
        "s5_b_im": nrm((N_AB, G_A, N_A, GS_A), (2 * GS_A) ** -0.5),
        "s5_c_re": nrm((N_AB, G_A, GS_A, N_A), N_A ** -0.5),
        "s5_c_im": nrm((N_AB, G_A, GS_A, N_A), N_A ** -0.5),
        "s5_d": nrm((N_AB, D_A), 0.5),
        "s5_log_step": jax.random.uniform(next(ks), (N_AB, G_A), f32, math.log(1e-3), math.log(1e-1)),
        "s5_w_glu": nrm((N_AB, D_A, D_A), D_A ** -0.5),
        "s5_b_glu": nrm((N_AB, D_A), 0.02),
        "hg_lb_logits": nrm((N_AB, D_B), 0.1),
        "hg_norm_w": 1.0 + nrm((N_AB, V_B), 0.02),
        "w_out_ab": nrm((N_AB, D_A + D_B, D_MODEL), (D_A + D_B) ** -0.5),
        "w_in_c": nrm((N_C, D_MODEL, 2 * D_RNN), D_MODEL ** -0.5),
        "conv_w": nrm((N_C, CONV_W, D_RNN), CONV_W ** -0.5),
        "conv_b": nrm((N_C, D_RNN), 0.02),
        "w_gate_a": nrm((N_C, NB_C, BS_C, BS_C), BS_C ** -0.5),
        "b_gate_a": nrm((N_C, D_RNN), 0.02),
        "w_gate_x": nrm((N_C, NB_C, BS_C, BS_C), BS_C ** -0.5),
        "b_gate_x": nrm((N_C, D_RNN), 0.02),
        "lru_lambda": jnp.log(p) - jnp.log1p(-p),
        "w_out_c": nrm((N_C, D_RNN, D_MODEL), D_RNN ** -0.5),
    }


def reference(x_prompt, x_sample, state_s5_re, state_s5_im, state_hgrn, state_lru, state_conv,
              c_prompt, c_sample, norm_w, final_norm_w, w_ada, b_ada, w_ffn_gu, w_ffn_d,
              w_in_ab, s5_lam_re, s5_lam_im, s5_b_re, s5_b_im, s5_c_re, s5_c_im, s5_d, s5_log_step,
              s5_w_glu, s5_b_glu, hg_lb_logits, hg_norm_w, w_out_ab, w_in_c, conv_w, conv_b,
              w_gate_a, b_gate_a, w_gate_x, b_gate_x, lru_lambda, w_out_c):
    P = dict(norm_w=norm_w, final_norm_w=final_norm_w, w_ada=w_ada, b_ada=b_ada,
             w_ffn_gu=w_ffn_gu, w_ffn_d=w_ffn_d, w_in_ab=w_in_ab,
             s5_lam_re=s5_lam_re, s5_lam_im=s5_lam_im, s5_b_re=s5_b_re, s5_b_im=s5_b_im,
             s5_c_re=s5_c_re, s5_c_im=s5_c_im, s5_d=s5_d, s5_log_step=s5_log_step,
             s5_w_glu=s5_w_glu, s5_b_glu=s5_b_glu, hg_lb_logits=hg_lb_logits, hg_norm_w=hg_norm_w,
             w_out_ab=w_out_ab, w_in_c=w_in_c, conv_w=conv_w, conv_b=conv_b,
             w_gate_a=w_gate_a, b_gate_a=b_gate_a, w_gate_x=w_gate_x, b_gate_x=b_gate_x,
             lru_lambda=lru_lambda, w_out_c=w_out_c)
    dt = x_prompt.dtype
    z_s5 = jnp.zeros((N_AB, BATCH, G_A, N_A), dt)
    z_hg = jnp.zeros((N_AB, BATCH, H_B, K_B, V_B), dt)
    z_lru = jnp.zeros((N_C, BATCH, D_RNN), dt)
    z_conv = jnp.zeros((N_C, BATCH, CONV_W - 1, D_RNN), dt)
    y_prompt, p_s5r, p_s5i, p_hg, p_lru, p_conv = run_group(x_prompt, c_prompt, z_s5, z_s5, z_hg, z_lru, z_conv, P)
    y_sample, s_s5r, s_s5i, s_hg, s_lru, s_conv = run_group(x_sample, c_sample, state_s5_re, state_s5_im,
                                                           state_hgrn, state_lru, state_conv, P)
    return (y_prompt, y_sample, p_s5r, p_s5i, p_hg, p_lru, p_conv, s_s5r, s_s5i, s_hg, s_lru, s_conv)
```

```cpp
#include <hip/hip_runtime.h>
#include <cstdio>
#include <cstdint>

namespace pg8 {
#define PG8_LAS __attribute__((address_space(3)))
typedef unsigned short bf16_t;
typedef short bf16x8 __attribute__((ext_vector_type(8)));
typedef float f32x4 __attribute__((ext_vector_type(4)));
typedef unsigned u32x4 __attribute__((ext_vector_type(4)));
constexpr int BM = 256, BK = 64, HALF = 128, HTB = HALF * BK * 2  , STAGE_BYTES = 8 * HTB, NXCD = 8, WGM = 8;

__host__ __device__ __forceinline__ int lds_byte(int r, int c) { const int st = (r >> 4) * 2 + (c >> 5), rr = r & 15, cc = c & 31, ob = rr * 64 + cc * 2; return st * 1024 + (ob ^ (((ob >> 9) & 1) << 5)); }
__host__ __device__ __forceinline__ void stage_rc(int b, int& R, int& C) { const int st = b / 1024, sb = b % 1024, swz = sb ^ (((sb >> 9) & 1) << 5); R = (st >> 1) * 16 + swz / 64; C = (st & 1) * 32 + (swz % 64) / 2; }
__host__ __device__ __forceinline__ int perm32(int rho) { const int n = rho >> 4, i = rho & 15; return 8 * (i >> 2) + 4 * n + (i & 3); }

struct Unit { int pm, pn, ks; };
struct Gemm { const bf16_t* A; const bf16_t* Bt; int lda, ldb, K; };

struct StaticOrder {
    int nM, nN, nwg, G, c;
    __host__ __device__ void init(int nM_, int nN_, int G_, int c_) { nM = nM_; nN = nN_; nwg = nM * nN; G = G_; c = c_; }
    __host__ __device__ bool next(int i, Unit& u) const {
        const long L = (long)i * G + c; if (L >= nwg) return false;
        int wgid = (int)L; { const int q = nwg / NXCD, r = nwg % NXCD, xcd = wgid % NXCD, off = wgid / NXCD; wgid = (xcd < r ? xcd * (q + 1) : r * (q + 1) + (xcd - r) * q) + off; }
        const int nig = WGM * nN, gid = wgid / nig, fm = gid * WGM, gsz = (nM - fm) < WGM ? (nM - fm) : WGM;
        u.pm = fm + ((wgid % nig) % gsz); u.pn = (wgid % nig) / gsz; u.ks = 0; return true;
    }
    __device__ __forceinline__ int koff(const Unit&) const { return 0; }
    __device__ __forceinline__ int koffB(const Unit&) const { return 0; }
    __device__ __forceinline__ void a_ready(const Unit&) const {}
    __device__ __forceinline__ void done(const Unit&) const {}
};
struct GateOrder : StaticOrder {
    __device__ __forceinline__ int koff(const Unit& u) const { const int k0 = ((u.pn * 128) / 160) * 160; return k0 < 2176 ? k0 : 2176; }
    __device__ __forceinline__ int koffB(const Unit& u) const { return koff(u); }
};

struct SplitKOrder {
    int pm, nN, nwg, G, c, klen;
    __host__ __device__ void init(int pm_, int nN_, int nK_, int klen_, int G_, int c_) { pm = pm_; nN = nN_; nwg = nN_ * nK_; klen = klen_; G = G_; c = c_; }
    __host__ __device__ bool next(int i, Unit& u) const { const long L = (long)i * G + c; if (L >= nwg) return false; u.pm = pm; u.pn = (int)L % nN; u.ks = (int)L / nN; return true; }
    __device__ __forceinline__ int koff(const Unit& u) const { return u.ks * klen; }
    __device__ __forceinline__ int koffB(const Unit& u) const { return u.ks * klen; }
    __device__ __forceinline__ void a_ready(const Unit&) const {}
    __device__ __forceinline__ void done(const Unit&) const {}
};

__device__ __forceinline__ unsigned cvt_pk_bf16(float lo, float hi) { unsigned r; asm volatile("v_cvt_pk_bf16_f32 %0, %1, %2" : "=v"(r) : "v"(lo), "v"(hi)); return r; }

template <class Epi, class Sched, bool ALIGN_EPI = false, bool SP2 = false>
__device__ __forceinline__ void gemm_phase(PG8_LAS unsigned char* lds, const Gemm g, const Sched& S, const Epi& E, const int tid_in) {
    int tid_ = tid_in; asm volatile("" : "+v"(tid_));
    const int tid = tid_, wid = __builtin_amdgcn_readfirstlane(tid >> 6), lane = tid & 63, wr = wid >> 2, wc = wid & 3, fr = lane & 15, fq = lane >> 4;
    const int K = g.K, nt = K / BK;
    unsigned voffA[2], voffB[2];
#pragma unroll
    for (int i = 0; i < 2; ++i) { int R, C; stage_rc(tid * 16 + i * 8192, R, C); const int Rb = Epi::PERM ? ((R & ~31) + perm32(R & 31)) : R;
        voffA[i] = (unsigned)(R * g.lda + C) * 2u; voffB[i] = (unsigned)(Rb * g.ldb + C) * 2u; }
    const size_t kstep = (size_t)(BK * 2);
    const size_t hstepA = (size_t)HALF * g.lda * 2, hstepB = (size_t)HALF * g.ldb * 2;
    const size_t tstepA = 2 * hstepA, tstepB = 2 * hstepB;
    const unsigned ldsw = (unsigned)wid * 1024u;
    const int aoff = lds_byte(wr * 64 + fr, fq * 8), boff = lds_byte(wc * 32 + fr, fq * 8);
#define PG8_SA(b, h) (((b) * 2 + (h)) * HTB)
#define PG8_SB(b, h) ((4 + (b) * 2 + (h)) * HTB)
#define PG8_STAGE(bufoff, gbase, voff) do { _Pragma("unroll") for (int _i = 0; _i < 2; ++_i) \
        __builtin_amdgcn_global_load_lds((const unsigned*)((const char*)(gbase) + (voff)[_i]), (PG8_LAS unsigned*)(lds + (bufoff) + ldsw + _i * 8192), 16, 0, 0); } while (0)
#define PG8_LDA(dst, b, h) do { _Pragma("unroll") for (int m = 0; m < 4; ++m) _Pragma("unroll") for (int k = 0; k < 2; ++k) dst[m][k] = *(const PG8_LAS bf16x8*)(lds + PG8_SA(b, h) + aoff + m * 2048 + k * 1024); } while (0)
#define PG8_LDB(dst, b, h) do { _Pragma("unroll") for (int n = 0; n < 2; ++n) _Pragma("unroll") for (int k = 0; k < 2; ++k) dst[n][k] = *(const PG8_LAS bf16x8*)(lds + PG8_SB(b, h) + boff + n * 2048 + k * 1024); } while (0)
#define PG8_MMA(ai, bj, At, Bt) do { __builtin_amdgcn_s_setprio(1); _Pragma("unroll") for (int m = 0; m < 4; ++m) _Pragma("unroll") for (int n = 0; n < 2; ++n) _Pragma("unroll") for (int k = 0; k < 2; ++k) \
        acc[ai][bj][m][n] = __builtin_amdgcn_mfma_f32_16x16x32_bf16(Bt[n][k], At[m][k], acc[ai][bj][m][n], 0, 0, 0); __builtin_amdgcn_s_setprio(0); } while (0)
#define PG8_WAIT_V(n) asm volatile("s_waitcnt vmcnt(" #n ")" ::: "memory")
#define PG8_WAIT_L(n) asm volatile("s_waitcnt lgkmcnt(" #n ")" ::: "memory")
#define PG8_BAR __builtin_amdgcn_s_barrier()
#define PG8_SCHED __builtin_amdgcn_sched_barrier(0)
    Unit cur, nxt; int ui = 0;
    if (!S.next(0, cur)) return;
    f32x4 acc[2][2][4][2];
#pragma unroll
    for (int a = 0; a < 2; ++a)
#pragma unroll
        for (int b = 0; b < 2; ++b)
#pragma unroll
            for (int m = 0; m < 4; ++m)
#pragma unroll
                for (int n = 0; n < 2; ++n) acc[a][b][m][n] = (f32x4){0.f, 0.f, 0.f, 0.f};
    bf16x8 At[4][2], B0[2][2], B1[2][2];
    const char* cA = (const char*)g.A + (size_t)cur.pm * tstepA + (size_t)S.koff(cur) * 2; const char* cB = (const char*)g.Bt + (size_t)cur.pn * tstepB + (size_t)S.koffB(cur) * 2;
    S.a_ready(cur);
    if constexpr (SP2) {
        PG8_STAGE(PG8_SB(0, 0), cB, voffB); PG8_STAGE(PG8_SB(0, 1), cB + hstepB, voffB); PG8_STAGE(PG8_SA(0, 0), cA, voffA); PG8_STAGE(PG8_SA(0, 1), cA + hstepA, voffA);
        if (wr == 1) PG8_BAR;
        PG8_WAIT_V(2); PG8_BAR;
        PG8_STAGE(PG8_SB(1, 0), cB + kstep, voffB); PG8_STAGE(PG8_SA(1, 0), cA + kstep, voffA); PG8_STAGE(PG8_SB(1, 1), cB + hstepB + kstep, voffB);
        PG8_WAIT_V(6); PG8_BAR;
    } else {
        PG8_STAGE(PG8_SB(0, 0), cB, voffB); PG8_STAGE(PG8_SA(0, 0), cA, voffA); PG8_STAGE(PG8_SB(0, 1), cB + hstepB, voffB); PG8_STAGE(PG8_SA(0, 1), cA + hstepA, voffA);
        if (wr == 1) PG8_BAR;
        PG8_WAIT_V(4); PG8_BAR;
        PG8_STAGE(PG8_SB(1, 0), cB + kstep, voffB); PG8_STAGE(PG8_SA(1, 0), cA + kstep, voffA); PG8_STAGE(PG8_SB(1, 1), cB + hstepB + kstep, voffB);
        PG8_WAIT_V(6); PG8_BAR;
    }
    for (;;) {
        const bool has_next = S.next(ui + 1, nxt);
        const char* nA = has_next ? (const char*)g.A + (size_t)nxt.pm * tstepA + (size_t)S.koff(nxt) * 2 : cA; const char* nB = has_next ? (const char*)g.Bt + (size_t)nxt.pn * tstepB + (size_t)S.koffB(nxt) * 2 : cB;
#pragma unroll 1
        for (int t = 0; t < nt; t += 2) {
            const bool last = (t == nt - 2);
            const char* a1 = cA + (size_t)(t + 1) * kstep;
            const char* a2 = last ? nA : cA + (size_t)(t + 2) * kstep; const char* b2 = last ? nB : cB + (size_t)(t + 2) * kstep;
            const char* a3 = a2 + kstep; const char* b3 = b2 + kstep;
            if (last && has_next) S.a_ready(nxt);
            if constexpr (SP2) {
            PG8_LDB(B0, 0, 0); PG8_LDB(B1, 0, 1); PG8_SCHED; PG8_LDA(At, 0, 0); PG8_STAGE(PG8_SA(1, 1), a1 + hstepA, voffA);
            PG8_WAIT_V(8); PG8_WAIT_L(0); PG8_BAR; PG8_MMA(0, 0, At, B0); PG8_MMA(0, 1, At, B1); PG8_BAR; PG8_SCHED;
            PG8_LDA(At, 0, 1); PG8_STAGE(PG8_SB(0, 0), b2, voffB); PG8_STAGE(PG8_SB(0, 1), b2 + hstepB, voffB); PG8_STAGE(PG8_SA(0, 0), a2, voffA);
            PG8_WAIT_V(8); PG8_WAIT_L(0); PG8_BAR; PG8_MMA(1, 0, At, B0); PG8_MMA(1, 1, At, B1); PG8_BAR; PG8_SCHED;
            PG8_LDB(B0, 1, 0); PG8_LDB(B1, 1, 1); PG8_SCHED; PG8_LDA(At, 1, 0); PG8_STAGE(PG8_SA(0, 1), a2 + hstepA, voffA);
            PG8_WAIT_V(8); PG8_WAIT_L(0); PG8_BAR; PG8_MMA(0, 0, At, B0); PG8_MMA(0, 1, At, B1); PG8_BAR; PG8_SCHED;
            PG8_LDA(At, 1, 1); PG8_STAGE(PG8_SB(1, 0), b3, voffB); PG8_STAGE(PG8_SB(1, 1), b3 + hstepB, voffB); PG8_STAGE(PG8_SA(1, 0), a3, voffA);
            PG8_WAIT_V(8); PG8_WAIT_L(0); PG8_BAR; PG8_MMA(1, 0, At, B0); PG8_MMA(1, 1, At, B1); PG8_BAR; PG8_SCHED;
            } else {
            PG8_LDB(B0, 0, 0); PG8_SCHED; PG8_LDA(At, 0, 0); PG8_STAGE(PG8_SA(1, 1), a1 + hstepA, voffA);
            PG8_WAIT_L(8); PG8_BAR; PG8_WAIT_L(0); PG8_MMA(0, 0, At, B0); PG8_BAR; PG8_SCHED;
            PG8_LDB(B1, 0, 1); PG8_STAGE(PG8_SB(0, 0), b2, voffB);
            PG8_BAR; PG8_WAIT_L(0); PG8_MMA(0, 1, At, B1); PG8_BAR;
            PG8_LDA(At, 0, 1); PG8_STAGE(PG8_SA(0, 0), a2, voffA);
            PG8_BAR; PG8_WAIT_L(0); PG8_MMA(1, 0, At, B0); PG8_BAR; PG8_SCHED;
            PG8_STAGE(PG8_SB(0, 1), b2 + hstepB, voffB);
            PG8_WAIT_V(6); PG8_BAR; PG8_MMA(1, 1, At, B1); PG8_BAR;
            PG8_LDB(B0, 1, 0); PG8_SCHED; PG8_LDA(At, 1, 0); PG8_STAGE(PG8_SA(0, 1), a2 + hstepA, voffA);
            PG8_WAIT_L(8); PG8_BAR; PG8_WAIT_L(0); PG8_MMA(0, 0, At, B0); PG8_BAR; PG8_SCHED;
            PG8_LDB(B1, 1, 1); PG8_STAGE(PG8_SB(1, 0), b3, voffB);
            PG8_BAR; PG8_WAIT_L(0); PG8_MMA(0, 1, At, B1); PG8_BAR;
            PG8_LDA(At, 1, 1); PG8_STAGE(PG8_SA(1, 0), a3, voffA);
            PG8_BAR; PG8_WAIT_L(0); PG8_MMA(1, 0, At, B0); PG8_BAR; PG8_SCHED;
            PG8_STAGE(PG8_SB(1, 1), b3 + hstepB, voffB);
            PG8_WAIT_V(6); PG8_BAR; PG8_MMA(1, 1, At, B1); PG8_BAR;
            }
        }
        if constexpr (ALIGN_EPI) { if (wr == 0) PG8_BAR; }
        if constexpr (!Epi::AFTER_DRAIN) { E(acc, cur, wr, wc, fr, fq); S.done(cur); }
        if (!has_next) break;
#pragma unroll
        for (int a = 0; a < 2; ++a)
#pragma unroll
            for (int b = 0; b < 2; ++b)
#pragma unroll
                for (int m = 0; m < 4; ++m)
#pragma unroll
                    for (int n = 0; n < 2; ++n) acc[a][b][m][n] = (f32x4){0.f, 0.f, 0.f, 0.f};
        cur = nxt; cA = nA; cB = nB; ++ui;
        if constexpr (ALIGN_EPI) { if (wr == 1) PG8_BAR; }
    }
    PG8_WAIT_V(0);
    if constexpr (!ALIGN_EPI) { if (wr == 0) PG8_BAR; }
    PG8_BAR;
    if constexpr (Epi::AFTER_DRAIN) { E.fused(acc, cur, wr, wc, fr, fq, lds, wid, lane); S.done(cur); }
#undef PG8_SA
#undef PG8_SB
#undef PG8_STAGE
#undef PG8_LDA
#undef PG8_LDB
#undef PG8_MMA
#undef PG8_WAIT_V
#undef PG8_WAIT_L
#undef PG8_BAR
#undef PG8_SCHED
}
}

using pg8::f32x4; using pg8::u32x4; using pg8::Unit; using pg8::cvt_pk_bf16;
typedef unsigned short bf16;
typedef float f32x2 __attribute__((ext_vector_type(2)));
typedef unsigned u32x2 __attribute__((ext_vector_type(2)));
#define LAS __attribute__((address_space(3)))
constexpr int NWAVES = 8, NTHR = 512;
constexpr int D = 2048, TP = 8192, TS = 128, TT = 8320, MP = 8448, NPAN = 33;
constexpr int DFF = 5376, DIN = 5120, DRNN = 2560, DA = 1024;
constexpr int NMODW = 18432, MODLD = 73728;
constexpr float EPS = 1e-6f;
constexpr int LDS_BYTES = 147456;
constexpr int MISC_OFF = 131072 + 320;

constexpr size_t al256(size_t x) { return (x + 255) & ~(size_t)255; }
constexpr size_t WS_CTL = 0, CTL_BYTES = 1u << 20;
constexpr size_t WS_WGU = WS_CTL + CTL_BYTES;
constexpr size_t WS_WD = WS_WGU + (size_t)8 * 10752 * 2048 * 2;
constexpr size_t WS_WINAB = WS_WD + (size_t)8 * 2048 * 5376 * 2;
constexpr size_t WS_WGLU = WS_WINAB + (size_t)2 * 5120 * 2048 * 2;
constexpr size_t WS_WOUTAB = WS_WGLU + (size_t)2 * 1024 * 1024 * 2;
constexpr size_t WS_WINC = WS_WOUTAB + (size_t)2 * 2048 * 2048 * 2;
constexpr size_t WS_WOUTC = WS_WINC + (size_t)2 * 5120 * 2048 * 2;
constexpr size_t WS_WGATE = WS_WOUTC + (size_t)2 * 2048 * 2560 * 2;
constexpr size_t WS_WADA = WS_WGATE + (size_t)2 * 5120 * 2560 * 2;
constexpr size_t WS_SC = WS_WADA + (size_t)73728 * 2048 * 2;
constexpr size_t WS_MOD = WS_SC + (size_t)256 * 2048 * 2;
constexpr size_t WS_X = WS_MOD + (size_t)256 * 73728 * 4;
constexpr size_t WS_H = WS_X + (size_t)MP * D * 4;
constexpr size_t WS_HID = WS_H + (size_t)MP * D * 2;
constexpr size_t WS_Z = WS_HID + (size_t)MP * DFF * 2;
constexpr size_t WS_XR = WS_Z + (size_t)MP * DIN * 2;
constexpr size_t WS_XC = WS_XR + (size_t)MP * DRNN * 4;
constexpr size_t WS_XCB = WS_XC + (size_t)MP * DRNN * 4;
constexpr size_t WS_AA = WS_XCB + (size_t)MP * DRNN * 2;
constexpr size_t WS_BB = WS_AA + (size_t)MP * DRNN * 4;
constexpr size_t WS_MIX = WS_BB + (size_t)MP * DRNN * 4;
constexpr size_t WS_YA = WS_MIX + (size_t)MP * DRNN * 2;
constexpr size_t WS_OB = WS_YA + (size_t)MP * DA * 2;
constexpr size_t WS_S5E = WS_OB + (size_t)TP * 1024 * 4;
constexpr size_t WS_LRUP = WS_S5E + (size_t)4 * 64 * 8 * 128 * 4;
constexpr size_t WS_LB = WS_LRUP + (size_t)4 * 16 * 2560 * 2 * 4;
constexpr size_t WS_LL = WS_LB + 2 * 1024 * 4;
constexpr size_t WS_PART = WS_LL + 2 * 2560 * 4;
constexpr size_t WS_END = WS_PART + (size_t)21 * 128 * 2048 * 4;
constexpr size_t WS_HT = WS_XR, WS_HS = WS_XC, WS_QG = WS_AA, WS_HD = WS_BB;
constexpr int CW_BAR = 4096;

constexpr size_t O_Y = 0;
constexpr size_t O_PS5R = (size_t)TT * D;
constexpr size_t O_PS5I = O_PS5R + 2 * 4 * 64 * 64;
constexpr size_t O_PHG = O_PS5I + 2 * 4 * 64 * 64;
constexpr size_t O_PLRU = O_PHG + (size_t)2 * 4 * 8 * 128 * 128;
constexpr size_t O_PCONV = O_PLRU + 2 * 4 * 2560;
constexpr size_t O_SS5R = O_PCONV + 2 * 4 * 3 * 2560;
constexpr size_t O_SS5I = O_SS5R + (size_t)2 * 128 * 64 * 64;
constexpr size_t O_SHG = O_SS5I + (size_t)2 * 128 * 64 * 64;
constexpr size_t O_SLRU = O_SHG + (size_t)2 * 128 * 8 * 128 * 128;
constexpr size_t O_SCONV = O_SLRU + (size_t)2 * 128 * 2560;
constexpr size_t O_END = O_SCONV + (size_t)2 * 128 * 3 * 2560;

enum { I_XP = 0, I_XS, I_S5RE, I_S5IM, I_HG, I_LRU, I_CONV, I_CP, I_CS, I_NW, I_FNW, I_WADA, I_BADA, I_WGU, I_WD, I_WINAB, I_LAMRE, I_LAMIM, I_BRE, I_BIM, I_CRE, I_CIM, I_S5D, I_LSTEP,
       I_WGLU, I_BGLU, I_LBL, I_HGNW, I_WOUTAB, I_WINC, I_CONVW, I_CONVB, I_WGA, I_BGA, I_WGX, I_BGX, I_LAMBDA, I_WOUTC, N_IN };

__device__ __forceinline__ float bflo(unsigned w) { return __uint_as_float(w << 16); }
__device__ __forceinline__ float bfhi(unsigned w) { return __uint_as_float(w & 0xffff0000u); }
__device__ __forceinline__ float fsigmoid(float x) { return __builtin_amdgcn_rcpf(1.0f + __expf(-x)); }
__device__ __forceinline__ float fsilu(float x) { return x * fsigmoid(x); }
__device__ __forceinline__ float fgelu(float x) { const float u = 0.7978845608f * (x + 0.044715f * x * x * x); return x * fsigmoid(2.0f * u); }
__device__ __forceinline__ int mrow_of(int row) { return row < TP ? (row >> 11) : ((row - TP + 4) < 131 ? (row - TP + 4) : 131); }
#define DPP_F(p, ctrl) __int_as_float(__builtin_amdgcn_update_dpp(0, __float_as_int(p), (ctrl), 0xF, 0xF, true))
__device__ __forceinline__ float row16_sum(float p) { p += DPP_F(p, 0xB1); p += DPP_F(p, 0x4E); p += DPP_F(p, 0x141); p += DPP_F(p, 0x140); return p; }
__device__ __forceinline__ float wave_sum(float v) {
    v = row16_sum(v); const int b = __float_as_int(v);
    return (__int_as_float(__builtin_amdgcn_readlane(b, 0)) + __int_as_float(__builtin_amdgcn_readlane(b, 16))) + (__int_as_float(__builtin_amdgcn_readlane(b, 32)) + __int_as_float(__builtin_amdgcn_readlane(b, 48)));
}
__device__ __forceinline__ float swz_xor16(float v) { return __int_as_float(__builtin_amdgcn_ds_swizzle(__float_as_int(v), 0x401F)); }
__device__ __forceinline__ float oct_sum(float p) { p += DPP_F(p, 0xB1); p += DPP_F(p, 0x4E); p += DPP_F(p, 0x141); return p; }
__device__ __forceinline__ void sincos_acc(float x, float& s, float& c) {
    const float k = rintf(x * 0.636619772f);
    float y = fmaf(k, -1.5703125f, x); y = fmaf(k, -4.837512969970703125e-4f, y); y = fmaf(k, -7.54978995489188216e-8f, y);
    const float y2 = y * y;
    float sp = fmaf(y2, 2.7557319e-6f, -1.9841270e-4f); sp = fmaf(sp, y2, 8.3333333e-3f); sp = fmaf(sp, y2, -1.6666667e-1f); sp = fmaf(sp * y2, y, y);
    float cp = fmaf(y2, -2.7557319e-7f, 2.4801587e-5f); cp = fmaf(cp, y2, -1.3888889e-3f); cp = fmaf(cp, y2, 4.1666667e-2f); cp = fmaf(cp, y2, -0.5f); cp = fmaf(cp, y2, 1.0f);
    const int q = ((int)k) & 3;
    s = (q == 0) ? sp : (q == 1) ? cp : (q == 2) ? -sp : -cp;
    c = (q == 0) ? cp : (q == 1) ? -sp : (q == 2) ? -cp : sp;
}

#define XB_TMO      128
#define XB_XCNT(j)  (256  + 64 * (j))
#define XB_XSUB(j)  (1280 + 64 * (j))
#define XB_XGEN(j)  (2304 + 64 * (j))
#define XB_TOP      3328
#define XB_TOPGEN   3392
#define XCD_BAR_WORDS 3456
#define XB_SPIN_CAP (1u << 18)
__device__ __forceinline__ unsigned xb_ld(unsigned* p)              { return __hip_atomic_load(p, __ATOMIC_RELAXED, __HIP_MEMORY_SCOPE_AGENT); }
__device__ __forceinline__ unsigned xb_add(unsigned* p, unsigned v) { return __hip_atomic_fetch_add(p, v, __ATOMIC_RELAXED, __HIP_MEMORY_SCOPE_AGENT); }
__device__ __forceinline__ unsigned xb_xcc_id() { return (unsigned)__builtin_amdgcn_s_getreg((3 << 11) | 20) & 0xFu; }
#define XB_SPIN(cond, bar) do { unsigned _sp = 0; while (cond) { __builtin_amdgcn_s_sleep(1); \
    if ((++_sp & 255u) == 0u) { if (xb_ld(&(bar)[XB_TMO])) break; if (_sp > XB_SPIN_CAP) { atomicAdd(&(bar)[XB_TMO], 1u); break; } } } } while (0)
struct XcdBarrier { unsigned* bar; unsigned x; volatile LAS unsigned* st; int wid; };
__device__ __forceinline__ bool xb_leader(int wid) { return wid == 0 && __builtin_amdgcn_mbcnt_hi(~0u, __builtin_amdgcn_mbcnt_lo(~0u, 0u)) == 0u; }
__device__ __forceinline__ XcdBarrier xcd_barrier_post(unsigned* bar, volatile LAS unsigned* st, int wid) {
    XcdBarrier b; b.bar = bar; b.x = xb_xcc_id(); b.st = st; b.wid = wid;
    if (xb_leader(wid)) (void)xb_add(&bar[XB_XCNT(b.x)], 1u);
    return b;
}
__device__ __forceinline__ void xcd_barrier_complete(unsigned* bar, unsigned x, unsigned& nloc, unsigned& nx) {
    const unsigned G = gridDim.x * gridDim.y * gridDim.z;
    unsigned sum, cnt, mine, sp = 0u;
    for (;;) {
        sum = 0u; cnt = 0u; mine = 0u;
#pragma unroll
        for (unsigned j = 0; j < 16; ++j) { const unsigned c = xb_ld(&bar[XB_XCNT(j)]); sum += c; cnt += (c > 0u) ? 1u : 0u; mine = (j == x) ? c : mine; }
        if (sum == G) break;
        __builtin_amdgcn_s_sleep(1);
        if ((++sp & 255u) == 0u) { if (xb_ld(&bar[XB_TMO])) break; if (sp > XB_SPIN_CAP) { atomicAdd(&bar[XB_TMO], 1u); break; } }
    }
    nloc = mine > 0u ? mine : 1u; nx = cnt > 0u ? cnt : 1u;
}
__device__ __forceinline__ void xcd_barrier(const XcdBarrier& b) {
    asm volatile("s_waitcnt vmcnt(0)" ::: "memory");
    __syncthreads();
    if (xb_leader(b.wid)) {
        unsigned* bar = b.bar;
        __builtin_amdgcn_s_waitcnt(0);
        unsigned nloc = b.st[0], nx = b.st[1];
        if (nloc == 0u) { xcd_barrier_complete(bar, b.x, nloc, nx); b.st[0] = nloc; b.st[1] = nx; }
        const unsigned old = xb_add(&bar[XB_XSUB(b.x)], 1u);
        const unsigned gen = old / nloc;
        if (old + 1u == (gen + 1u) * nloc) {
            __builtin_amdgcn_fence(__ATOMIC_RELEASE, "agent");
            asm volatile("s_waitcnt vmcnt(0)" ::: "memory");
            const unsigned og = xb_add(&bar[XB_TOP], 1u);
            const unsigned tg = og / nx;
            if (og + 1u == (tg + 1u) * nx) xb_add(&bar[XB_TOPGEN], 1u);
            else XB_SPIN(xb_ld(&bar[XB_TOPGEN]) == tg, bar);
            __builtin_amdgcn_fence(__ATOMIC_ACQUIRE, "agent");
            xb_add(&bar[XB_XGEN(b.x)], 1u);
            asm volatile("s_waitcnt vmcnt(0)" ::: "memory");
        } else {
            XB_SPIN(xb_ld(&bar[XB_XGEN(b.x)]) == gen, bar);
            __builtin_amdgcn_fence(__ATOMIC_ACQUIRE, "agent");
            asm volatile("s_waitcnt vmcnt(0)" ::: "memory");
        }
    }
    __syncthreads();
}

struct EpiF32B {
    static constexpr bool PERM = false, AFTER_DRAIN = false;
    float* C; int ldc; const float* bias;
    __device__ __forceinline__ void operator()(const f32x4 (&acc)[2][2][4][2], const Unit& u, int wr, int wc, int fr, int fq) const {
        const int row0 = u.pm * 256 + wr * 64 + fr, col0 = u.pn * 256 + wc * 32 + 4 * fq;
        f32x4 bv[2][2];
#pragma unroll
        for (int bj = 0; bj < 2; ++bj)
#pragma unroll
            for (int n = 0; n < 2; ++n) bv[bj][n] = *(const f32x4*)(bias + col0 + bj * 128 + n * 16);
#pragma unroll
        for (int ai = 0; ai < 2; ++ai)
#pragma unroll
            for (int m = 0; m < 4; ++m) { float* rowp = C + (size_t)(row0 + ai * 128 + m * 16) * ldc + col0;
#pragma unroll
                for (int bj = 0; bj < 2; ++bj)
#pragma unroll
                    for (int n = 0; n < 2; ++n) *(f32x4*)(rowp + bj * 128 + n * 16) = acc[ai][bj][m][n] + bv[bj][n]; }
    }
};
struct EpiBf16 {
    static constexpr bool PERM = true, AFTER_DRAIN = false;
    bf16* O; int ldc;
    __device__ __forceinline__ void operator()(const f32x4 (&acc)[2][2][4][2], const Unit& u, int wr, int wc, int fr, int fq) const {
        const int row0 = u.pm * 256 + wr * 64 + fr, col0 = u.pn * 256 + wc * 32 + 8 * fq;
#pragma unroll
        for (int ai = 0; ai < 2; ++ai)
#pragma unroll
            for (int m = 0; m < 4; ++m) { bf16* rowp = O + (size_t)(row0 + ai * 128 + m * 16) * ldc + col0;
#pragma unroll
                for (int bj = 0; bj < 2; ++bj) { const f32x4 v0 = acc[ai][bj][m][0], v1 = acc[ai][bj][m][1];
                    u32x4 w; w.x = cvt_pk_bf16(v0[0], v0[1]); w.y = cvt_pk_bf16(v0[2], v0[3]); w.z = cvt_pk_bf16(v1[0], v1[1]); w.w = cvt_pk_bf16(v1[2], v1[3]);
                    *(u32x4*)(rowp + bj * 128) = w; } }
    }
};
struct EpiGU {
    static constexpr bool PERM = true, AFTER_DRAIN = false;
    bf16* O;
    __device__ __forceinline__ void operator()(const f32x4 (&acc)[2][2][4][2], const Unit& u, int wr, int wc, int fr, int fq) const {
        const int row0 = u.pm * 256 + wr * 64 + fr, col0 = u.pn * 128 + wc * 32 + 8 * fq;
#pragma unroll
        for (int ai = 0; ai < 2; ++ai)
#pragma unroll
            for (int m = 0; m < 4; ++m) { bf16* rowp = O + (size_t)(row0 + ai * 128 + m * 16) * DFF + col0;
                float h[8];
#pragma unroll
                for (int n = 0; n < 2; ++n)
#pragma unroll
                    for (int i = 0; i < 4; ++i) h[4 * n + i] = fsilu(acc[ai][0][m][n][i]) * acc[ai][1][m][n][i];
                u32x4 w; w.x = cvt_pk_bf16(h[0], h[1]); w.y = cvt_pk_bf16(h[2], h[3]); w.z = cvt_pk_bf16(h[4], h[5]); w.w = cvt_pk_bf16(h[6], h[7]);
                *(u32x4*)rowp = w; }
    }
};
struct EpiRes {
    static constexpr bool PERM = false, AFTER_DRAIN = false;
    float* X; const float* mod; float scale;
    __device__ __forceinline__ void operator()(const f32x4 (&acc)[2][2][4][2], const Unit& u, int wr, int wc, int fr, int fq) const {
        const int row0 = u.pm * 256 + wr * 64 + fr, col0 = u.pn * 256 + wc * 32 + 4 * fq;
        float* xb = X + (size_t)row0 * D + col0; const float* mp = mod + (size_t)(row0 >> 11) * MODLD + col0;
        f32x4 g[2][2];
#pragma unroll
        for (int bj = 0; bj < 2; ++bj)
#pragma unroll
            for (int n = 0; n < 2; ++n) g[bj][n] = *(const f32x4*)(mp + bj * 128 + n * 16) * scale;
#pragma unroll
        for (int ai = 0; ai < 2; ++ai) { f32x4 xv[4][2][2];
#pragma unroll
            for (int m = 0; m < 4; ++m)
#pragma unroll
                for (int bj = 0; bj < 2; ++bj)
#pragma unroll
                    for (int n = 0; n < 2; ++n) xv[m][bj][n] = *(const f32x4*)(xb + (size_t)(ai * 128 + m * 16) * D + bj * 128 + n * 16);
#pragma unroll
            for (int m = 0; m < 4; ++m)
#pragma unroll
                for (int bj = 0; bj < 2; ++bj)
#pragma unroll
                    for (int n = 0; n < 2; ++n) *(f32x4*)(xb + (size_t)(ai * 128 + m * 16) * D + bj * 128 + n * 16) = xv[m][bj][n] + g[bj][n] * acc[ai][bj][m][n];
            asm volatile("" ::: "memory"); }
    }
};
struct EpiResPart {
    static constexpr bool PERM = false, AFTER_DRAIN = false;
    float* P; const float* mod; float scale;
    __device__ __forceinline__ void operator()(const f32x4 (&acc)[2][2][4][2], const Unit& u, int wr, int wc, int fr, int fq) const {
        const int row0 = u.pm * 256 + wr * 64 + fr, col0 = u.pn * 256 + wc * 32 + 4 * fq;
#pragma unroll
        for (int m = 0; m < 4; ++m) { const int row = row0 + m * 16;
            if (row < TT) { float* pp = P + ((size_t)u.ks * 128 + (row - TP)) * D + col0; const float* mp = mod + (size_t)mrow_of(row) * MODLD + col0;
#pragma unroll
                for (int bj = 0; bj < 2; ++bj)
#pragma unroll
                    for (int n = 0; n < 2; ++n) { const f32x4 g = *(const f32x4*)(mp + bj * 128 + n * 16); *(f32x4*)(pp + bj * 128 + n * 16) = (g * scale) * acc[0][bj][m][n]; } }
            asm volatile("" ::: "memory"); }
    }
};
struct EpiInC {
    static constexpr bool PERM = true, AFTER_DRAIN = false;
    bf16* GB; float* XR;
    __device__ __forceinline__ void operator()(const f32x4 (&acc)[2][2][4][2], const Unit& u, int wr, int wc, int fr, int fq) const {
        const int row0 = u.pm * 256 + wr * 64 + fr;
        if (u.pn < 10) { const int col0 = u.pn * 256 + wc * 32 + 8 * fq;
#pragma unroll
            for (int ai = 0; ai < 2; ++ai)
#pragma unroll
                for (int m = 0; m < 4; ++m) { bf16* rowp = GB + (size_t)(row0 + ai * 128 + m * 16) * DRNN + col0;
#pragma unroll
                    for (int bj = 0; bj < 2; ++bj) { const f32x4 v0 = acc[ai][bj][m][0], v1 = acc[ai][bj][m][1];
                        u32x4 w; w.x = cvt_pk_bf16(fgelu(v0[0]), fgelu(v0[1])); w.y = cvt_pk_bf16(fgelu(v0[2]), fgelu(v0[3])); w.z = cvt_pk_bf16(fgelu(v1[0]), fgelu(v1[1])); w.w = cvt_pk_bf16(fgelu(v1[2]), fgelu(v1[3]));
                        *(u32x4*)(rowp + bj * 128) = w; } }
        } else { const int col0 = (u.pn - 10) * 256 + wc * 32 + 8 * fq;
#pragma unroll
            for (int ai = 0; ai < 2; ++ai)
#pragma unroll
                for (int m = 0; m < 4; ++m) { float* rowp = XR + (size_t)(row0 + ai * 128 + m * 16) * DRNN + col0;
#pragma unroll
                    for (int bj = 0; bj < 2; ++bj) { *(f32x4*)(rowp + bj * 128) = acc[ai][bj][m][0]; *(f32x4*)(rowp + bj * 128 + 4) = acc[ai][bj][m][1]; } }
        }
    }
};
struct EpiGlu {
    static constexpr bool PERM = true, AFTER_DRAIN = false;
    bf16* O; const bf16* YA; const float* bias;
    __device__ __forceinline__ void operator()(const f32x4 (&acc)[2][2][4][2], const Unit& u, int wr, int wc, int fr, int fq) const {
        const int row0 = u.pm * 256 + wr * 64 + fr, col0 = u.pn * 256 + wc * 32 + 8 * fq;
        f32x4 bv[2][2];
#pragma unroll
        for (int bj = 0; bj < 2; ++bj)
#pragma unroll
            for (int n = 0; n < 2; ++n) bv[bj][n] = *(const f32x4*)(bias + col0 + bj * 128 + 4 * n);
#pragma unroll
        for (int ai = 0; ai < 2; ++ai)
#pragma unroll
            for (int m = 0; m < 4; ++m) { const size_t row = (size_t)(row0 + ai * 128 + m * 16);
#pragma unroll
                for (int bj = 0; bj < 2; ++bj) { const u32x4 yv = *(const u32x4*)(YA + row * DA + col0 + bj * 128);
                    const f32x4 v0 = acc[ai][bj][m][0] + bv[bj][0], v1 = acc[ai][bj][m][1] + bv[bj][1];
                    u32x4 w; w.x = cvt_pk_bf16(bflo(yv.x) * fsigmoid(v0[0]), bfhi(yv.x) * fsigmoid(v0[1])); w.y = cvt_pk_bf16(bflo(yv.y) * fsigmoid(v0[2]), bfhi(yv.y) * fsigmoid(v0[3]));
                    w.z = cvt_pk_bf16(bflo(yv.z) * fsigmoid(v1[0]), bfhi(yv.z) * fsigmoid(v1[1])); w.w = cvt_pk_bf16(bflo(yv.w) * fsigmoid(v1[2]), bfhi(yv.w) * fsigmoid(v1[3]));
                    *(u32x4*)(O + row * D + col0 + bj * 128) = w; }
                asm volatile("" ::: "memory"); }
    }
};
__device__ __forceinline__ float em1_neg(float x) { float p = fmaf(x, 1.0f / 720.0f, 1.0f / 120.0f); p = fmaf(p, x, 1.0f / 24.0f); p = fmaf(p, x, 1.0f / 6.0f); p = fmaf(p, x, 0.5f); p = fmaf(p, x, 1.0f); p *= x;
    return x > -0.25f ? p : __expf(x) - 1.0f; }
struct EpiGate {
    static constexpr bool PERM = false, AFTER_DRAIN = false;
    unsigned* AB; const float* XC; const float* bga; const float* bgx; const float* ll;
    __device__ __forceinline__ void operator()(const f32x4 (&acc)[2][2][4][2], const Unit& u, int wr, int wc, int fr, int fq) const {
        const int row0 = u.pm * 256 + wr * 64 + fr, ch0 = u.pn * 128 + wc * 32 + 4 * fq;
#pragma unroll
        for (int n = 0; n < 2; ++n) { const f32x4 ba = *(const f32x4*)(bga + ch0 + 16 * n), bx = *(const f32x4*)(bgx + ch0 + 16 * n), lv = *(const f32x4*)(ll + ch0 + 16 * n);
#pragma unroll
            for (int ai = 0; ai < 2; ++ai)
#pragma unroll
                for (int m = 0; m < 4; ++m) { const int row = row0 + ai * 128 + m * 16;
                    if (row < TT) { const size_t off = (size_t)row * DRNN + ch0 + 16 * n; const f32x4 xc = *(const f32x4*)(XC + off); u32x4 o;
#pragma unroll
                        for (int i = 0; i < 4; ++i) { const float r = fsigmoid(acc[ai][0][m][n][i] + ba[i]), ig = fsigmoid(acc[ai][1][m][n][i] + bx[i]);
                            const float la = r * lv[i]; o[i] = cvt_pk_bf16(la, sqrtf(fmaxf(-em1_neg(2.0f * la), 0.0f)) * ig * xc[i]); }
                        *(u32x4*)(AB + off) = o; }
                    asm volatile("" ::: "memory"); } }
    }
};


struct Args { const float* in[N_IN]; float* out; unsigned char* ws; int lo, hi; };
typedef const __attribute__((address_space(4))) unsigned long long* kargp_t;
__device__ __forceinline__ kargp_t kargs() { kargp_t p = (kargp_t)__builtin_amdgcn_kernarg_segment_ptr(); asm volatile("" : "+s"(p)); return p; }
#define INP(i) ((const float*)kargs()[(i)])
#define OUTP ((float*)kargs()[N_IN])
#define WSP ((unsigned char*)kargs()[N_IN + 1])
struct Frame { LAS unsigned char* lds; int tid, lane, wave, vcu, G, gw, NGW, gt, NT, bx; };

__device__ __forceinline__ void tr_item(const float* W, int ldw, int k0, int n0, bf16* WT, int ldk, int drow0, int lane) {
    const int n4 = (lane & 15) * 4, kg = lane >> 4; f32x4 v[2][8];
#pragma unroll
    for (int kh = 0; kh < 2; ++kh) { const float* src = W + (size_t)(k0 + kh * 32 + kg * 8) * ldw + n0 + n4;
#pragma unroll
        for (int i = 0; i < 8; ++i) v[kh][i] = __builtin_nontemporal_load((const f32x4*)(src + (size_t)i * ldw)); }
#pragma unroll
    for (int kh = 0; kh < 2; ++kh)
#pragma unroll
        for (int e = 0; e < 4; ++e) { u32x4 o; o.x = cvt_pk_bf16(v[kh][0][e], v[kh][1][e]); o.y = cvt_pk_bf16(v[kh][2][e], v[kh][3][e]); o.z = cvt_pk_bf16(v[kh][4][e], v[kh][5][e]); o.w = cvt_pk_bf16(v[kh][6][e], v[kh][7][e]);
            *(u32x4*)(WT + (size_t)(drow0 + n4 + e) * ldk + k0 + kh * 32 + kg * 8) = o; }
}
constexpr int IT_GU = 32 * 168, IT_D = 84 * 32, IT_INAB = 32 * 80, IT_GLU = 16 * 16, IT_OUTAB = 32 * 32, IT_INC = 32 * 80, IT_OUTC = 40 * 32;
constexpr int NITEMS_CONV = 8 * IT_GU + 8 * IT_D + 2 * IT_INAB + 2 * IT_GLU + 2 * IT_OUTAB + 2 * IT_INC + 2 * IT_OUTC;

__device__ __forceinline__ void conv_item(int it, int lane) {
    unsigned char* ws = WSP; int r = it;
    if (r < 8 * IT_GU) { const int idx = r / IT_GU; r -= idx * IT_GU; const int kb = r / 168, nb = r % 168, n0 = 64 * nb;
        const int drow = n0 < DFF ? (n0 >> 7) * 256 + (n0 & 127) : ((n0 - DFF) >> 7) * 256 + 128 + ((n0 - DFF) & 127);
        tr_item(INP(I_WGU) + (size_t)idx * 2048 * 10752, 10752, 64 * kb, n0, (bf16*)(ws + WS_WGU) + (size_t)idx * 10752 * 2048, 2048, drow, lane); return; }
    r -= 8 * IT_GU;
    if (r < 8 * IT_D) { const int idx = r / IT_D; r -= idx * IT_D; const int kb = r / 32, nb = r % 32;
        tr_item(INP(I_WD) + (size_t)idx * 5376 * 2048, 2048, 64 * kb, 64 * nb, (bf16*)(ws + WS_WD) + (size_t)idx * 2048 * 5376, 5376, 64 * nb, lane); return; }
    r -= 8 * IT_D;
    if (r < 2 * IT_INAB) { const int idx = r / IT_INAB; r -= idx * IT_INAB; const int kb = r / 80, nb = r % 80;
        tr_item(INP(I_WINAB) + (size_t)idx * 2048 * 5120, 5120, 64 * kb, 64 * nb, (bf16*)(ws + WS_WINAB) + (size_t)idx * 5120 * 2048, 2048, 64 * nb, lane); return; }
    r -= 2 * IT_INAB;
    if (r < 2 * IT_GLU) { const int idx = r / IT_GLU; r -= idx * IT_GLU; const int kb = r / 16, nb = r % 16;
        tr_item(INP(I_WGLU) + (size_t)idx * 1024 * 1024, 1024, 64 * kb, 64 * nb, (bf16*)(ws + WS_WGLU) + (size_t)idx * 1024 * 1024, 1024, 64 * nb, lane); return; }
    r -= 2 * IT_GLU;
    if (r < 2 * IT_OUTAB) { const int idx = r / IT_OUTAB; r -= idx * IT_OUTAB; const int kb = r / 32, nb = r % 32;
        tr_item(INP(I_WOUTAB) + (size_t)idx * 2048 * 2048, 2048, 64 * kb, 64 * nb, (bf16*)(ws + WS_WOUTAB) + (size_t)idx * 2048 * 2048, 2048, 64 * nb, lane); return; }
    r -= 2 * IT_OUTAB;
    if (r < 2 * IT_INC) { const int idx = r / IT_INC; r -= idx * IT_INC; const int kb = r / 80, nb = r % 80;
        tr_item(INP(I_WINC) + (size_t)idx * 2048 * 5120, 5120, 64 * kb, 64 * nb, (bf16*)(ws + WS_WINC) + (size_t)idx * 5120 * 2048, 2048, 64 * nb, lane); return; }
    r -= 2 * IT_INC;
    { const int idx = r / IT_OUTC; r -= idx * IT_OUTC; const int kb = r / 32, nb = r % 32;
      tr_item(INP(I_WOUTC) + (size_t)idx * 2560 * 2048, 2048, 64 * kb, 64 * nb, (bf16*)(ws + WS_WOUTC) + (size_t)idx * 2048 * 2560, 2560, 64 * nb, lane); }
}

constexpr int IT_LAYER = 2 * IT_GU + 2 * IT_D + IT_INAB + IT_GLU + IT_OUTAB;
static_assert(IT_LAYER == 2 * IT_GU + 2 * IT_D + IT_INC + IT_OUTC && 4 * IT_LAYER == NITEMS_CONV, "per-layer conversion item counts");
__device__ __forceinline__ void conv_ordered(int oi, int lane) {
    const int l = oi / IT_LAYER, j = l >> 1; int r = oi - l * IT_LAYER; int kind_base;
    const int B_D = 8 * IT_GU, B_INAB = B_D + 8 * IT_D, B_GLU = B_INAB + 2 * IT_INAB, B_OUTAB = B_GLU + 2 * IT_GLU, B_INC = B_OUTAB + 2 * IT_OUTAB, B_OUTC = B_INC + 2 * IT_INC;
    if (r < IT_GU) kind_base = (2 * l) * IT_GU;
    else if ((r -= IT_GU) < IT_D) kind_base = B_D + (2 * l) * IT_D;
    else { r -= IT_D;
        if ((l & 1) == 0) {
            if (r < IT_INAB) kind_base = B_INAB + j * IT_INAB;
            else if ((r -= IT_INAB) < IT_GLU) kind_base = B_GLU + j * IT_GLU;
            else if ((r -= IT_GLU) < IT_OUTAB) kind_base = B_OUTAB + j * IT_OUTAB;
            else { r -= IT_OUTAB; if (r < IT_GU) kind_base = (2 * l + 1) * IT_GU; else { r -= IT_GU; kind_base = B_D + (2 * l + 1) * IT_D; } }
        } else {
            if (r < IT_INC) kind_base = B_INC + j * IT_INC;
            else if ((r -= IT_INC) < IT_OUTC) kind_base = B_OUTC + j * IT_OUTC;
            else { r -= IT_OUTC; if (r < IT_GU) kind_base = (2 * l + 1) * IT_GU; else { r -= IT_GU; kind_base = B_D + (2 * l + 1) * IT_D; } }
        }
    }
    conv_item(kind_base + r, lane);
}
constexpr int CONV_IPW = 4;
constexpr int SLOT_GU = (256 - 106) * 8 * CONV_IPW, SLOT_IN = (256 - 148) * 8 * CONV_IPW;
constexpr int SLOT_LAYER = 2 * SLOT_GU + SLOT_IN;
constexpr int CONV_PRO = 4 * IT_LAYER - 3 * SLOT_LAYER > IT_LAYER ? 4 * IT_LAYER - 3 * SLOT_LAYER : IT_LAYER;
static_assert(CONV_PRO >= IT_LAYER && CONV_PRO + SLOT_LAYER >= 2 * IT_LAYER && CONV_PRO + 2 * SLOT_LAYER >= 3 * IT_LAYER && CONV_PRO + 3 * SLOT_LAYER >= 4 * IT_LAYER, "every layer's weights are converted before the layer starts");
__device__ __forceinline__ void conv_slot(const Frame& F, int l, int slot, int first_idle) {
    if (l >= 3 || F.bx < first_idle) return;
    const int start = CONV_PRO + l * SLOT_LAYER + (slot == 0 ? 0 : slot == 1 ? SLOT_GU : SLOT_GU + SLOT_IN), n = (slot == 1 ? SLOT_IN : SLOT_GU), nw = (256 - first_idle) * 8, w = (F.bx - first_idle) * 8 + F.wave;
    for (int q = 0; q < CONV_IPW; ++q) { const int it = start + q * nw + w; if (q * nw + w < n && it < NITEMS_CONV) conv_ordered(it, F.lane); }
}

__device__ __forceinline__ void phase_ada(const Frame& F, int item0, int istride) {
    unsigned char* ws = WSP; const bf16* SC = (const bf16*)(ws + WS_SC); float* MOD = (float*)(ws + WS_MOD);
    const int r = F.lane & 15, kq = F.lane >> 4;
    for (int item = item0; item < 1152; item += istride) { const int l = item / 288, n0 = (item % 288) * 64;
        const float* W = INP(I_WADA) + (size_t)l * 2048 * NMODW + (size_t)(kq * 8) * NMODW + n0 + 4 * r; const bf16* sp = SC + (size_t)r * D + kq * 8;
        f32x4 acc[9][4];
#pragma unroll
        for (int bt = 0; bt < 9; ++bt)
#pragma unroll
            for (int e = 0; e < 4; ++e) acc[bt][e] = (f32x4){0.f, 0.f, 0.f, 0.f};
#pragma unroll 2
        for (int ks = 0; ks < 64; ++ks) { f32x4 w[8];
#pragma unroll
            for (int i = 0; i < 8; ++i) w[i] = __builtin_nontemporal_load((const f32x4*)(W + (size_t)(ks * 32 + i) * NMODW));
            pg8::bf16x8 wb[4];
#pragma unroll
            for (int e = 0; e < 4; ++e) { u32x4 o; o.x = cvt_pk_bf16(w[0][e], w[1][e]); o.y = cvt_pk_bf16(w[2][e], w[3][e]); o.z = cvt_pk_bf16(w[4][e], w[5][e]); o.w = cvt_pk_bf16(w[6][e], w[7][e]); wb[e] = __builtin_bit_cast(pg8::bf16x8, o); }
#pragma unroll
            for (int bt = 0; bt < 9; ++bt) { const pg8::bf16x8 sa = *(const pg8::bf16x8*)(sp + (size_t)(bt * 16) * D + ks * 32);
#pragma unroll
                for (int e = 0; e < 4; ++e) acc[bt][e] = __builtin_amdgcn_mfma_f32_16x16x32_bf16(wb[e], sa, acc[bt][e], 0, 0, 0); }
        }
        const float* bias = INP(I_BADA) + (size_t)l * NMODW + n0 + 16 * kq; f32x4 bv[4];
#pragma unroll
        for (int t = 0; t < 4; ++t) bv[t] = *(const f32x4*)(bias + 4 * t);
#pragma unroll
        for (int bt = 0; bt < 9; ++bt) { const int brow = bt * 16 + r;
            if (brow < 132) { float* op = MOD + (size_t)brow * MODLD + (size_t)l * NMODW + n0 + 16 * kq;
#pragma unroll
                for (int t = 0; t < 4; ++t) *(f32x4*)(op + 4 * t) = (f32x4){acc[bt][0][t], acc[bt][1][t], acc[bt][2][t], acc[bt][3][t]} + bv[t]; } }
    }
}

__device__ __forceinline__ void phase_prologue(const Frame& F) {
    unsigned char* ws = WSP;
    { f32x4* X4 = (f32x4*)(ws + WS_X); const f32x4* xp = (const f32x4*)INP(I_XP); const f32x4* xs = (const f32x4*)INP(I_XS);
      for (int i = F.gt; i < MP * 512; i += F.NT) { const int row = i >> 9; f32x4 v = (f32x4){0.f, 0.f, 0.f, 0.f};
          if (row < TP) v = xp[i]; else if (row < TT) v = xs[i - TP * 512]; X4[i] = v; } }
    { u32x4* Hp = (u32x4*)(ws + WS_H + (size_t)TT * D * 2); for (int i = F.gt; i < (MP - TT) * D / 8; i += F.NT) Hp[i] = (u32x4){0u, 0u, 0u, 0u}; }
    { u32x2* S2 = (u32x2*)(ws + WS_SC);
      for (int i = F.gt; i < 256 * 512; i += F.NT) { const int row = i >> 9, c4 = i & 511; f32x4 v = (f32x4){0.f, 0.f, 0.f, 0.f};
          if (row < 4) v = ((const f32x4*)INP(I_CP))[row * 512 + c4]; else if (row < 132) v = ((const f32x4*)INP(I_CS))[(row - 4) * 512 + c4];
          u32x2 w; w.x = cvt_pk_bf16(fsilu(v[0]), fsilu(v[1])); w.y = cvt_pk_bf16(fsilu(v[2]), fsilu(v[3])); S2[i] = w; } }
    { float* LB = (float*)(ws + WS_LB); const float* lg = INP(I_LBL);
      for (int i = F.gt; i < 1024; i += F.NT) { const float l0 = lg[i], l1 = lg[1024 + i], mx = fmaxf(l0, l1), e0 = expf(l0 - mx), e1 = expf(l1 - mx), s0 = e0 / (e0 + e1), s1 = e1 / (e0 + e1);
          LB[i] = s0 - s0; LB[1024 + i] = (s0 + s1) - s0; } }
    { float* LL = (float*)(ws + WS_LL); const float* lam = INP(I_LAMBDA);
      for (int i = F.gt; i < 2 * DRNN; i += F.NT) LL[i] = -8.0f * log1pf(expf(-lam[i])); }
    { bf16* WG = (bf16*)(ws + WS_WGATE);
      for (int i = F.gt; i < 2 * 20 * 256 * 48; i += F.NT) { const int k8 = i % 48, r = (i / 48) & 255, pn = (i / (48 * 256)) % 20, j = i / (48 * 256 * 20);
          const int ch = 128 * pn + (r & 127), bl = ch / 160, jc = ch % 160; int ks = ((pn * 128) / 160) * 160; ks = ks < 2176 ? ks : 2176;
          const float* W = (r < 128 ? INP(I_WGA) : INP(I_WGX)) + (size_t)(j * 16 + bl) * 160 * 160 + jc; float v[8];
#pragma unroll
          for (int e = 0; e < 8; ++e) { const int ci = ks + k8 * 8 + e; const int cin = ci - bl * 160; v[e] = (cin >= 0 && cin < 160) ? W[(size_t)cin * 160] : 0.f; }
          u32x4 w; w.x = cvt_pk_bf16(v[0], v[1]); w.y = cvt_pk_bf16(v[2], v[3]); w.z = cvt_pk_bf16(v[4], v[5]); w.w = cvt_pk_bf16(v[6], v[7]);
          *(u32x4*)(WG + ((size_t)(j * 20 + pn) * 256 + r) * 2560 + ks + k8 * 8) = w; } }
}


__device__ __forceinline__ void phase_ada_conv(const Frame& F) {
    const int pair = F.bx >> 1, odd = F.bx & 1, nA = odd ? 4 : 5;
    if (F.G == 256) {
        if (F.wave < nA) phase_ada(F, pair * 9 + (odd ? 5 + F.wave : F.wave), 1152);
        else { const int cw = pair * 7 + (odd ? 3 + (F.wave - 4) : (F.wave - 5)); for (int it = cw; it < CONV_PRO; it += 896) conv_ordered(it, F.lane); }
    } else { phase_ada(F, F.gw, F.NGW); for (int it = F.gw; it < CONV_PRO; it += F.NGW) conv_ordered(it, F.lane); }
}

__device__ __forceinline__ float row_ss(const f32x4 (&v)[8]) { float s = 0.f;
#pragma unroll
    for (int jx = 0; jx < 8; ++jx) s += (v[jx][0] * v[jx][0] + v[jx][1] * v[jx][1]) + (v[jx][2] * v[jx][2] + v[jx][3] * v[jx][3]);
    return 1.0f / sqrtf(wave_sum(s) * (1.0f / D) + EPS); }
__device__ __forceinline__ void sample_row_fold(float* X, const float* PART, int row, int nsplit, int lane, f32x4 (&v)[8]) {
    f32x4* xr = (f32x4*)(X + (size_t)row * D) + lane;
#pragma unroll
    for (int jx = 0; jx < 8; ++jx) v[jx] = xr[64 * jx];
    if (nsplit > 0) {
        for (int ks = 0; ks < nsplit; ++ks) { const f32x4* pp = (const f32x4*)(PART + ((size_t)ks * 128 + (row - TP)) * D) + lane;
#pragma unroll
            for (int jx = 0; jx < 8; ++jx) v[jx] += pp[64 * jx]; }
#pragma unroll
        for (int jx = 0; jx < 8; ++jx) xr[64 * jx] = v[jx]; }
}
__device__ __forceinline__ void phase_norm(const Frame& F, int l, int which, int nsplit) {
    float* X = (float*)(WSP + WS_X); const float* PART = (const float*)(WSP + WS_PART); bf16* H = (bf16*)(WSP + WS_H); const float* MOD = (const float*)(WSP + WS_MOD);
    const float* nw = INP(I_NW) + (size_t)(l * 3 + which) * D; const float* mbase = MOD + (size_t)l * NMODW + (size_t)(3 * which) * D;
    LAS float* T = (LAS float*)F.lds;
    for (int i = F.tid; i < 4 * 512; i += NTHR) { const int b = i >> 9, c4 = (i & 511) * 4; const f32x4 w = *(const f32x4*)(nw + c4), sh = *(const f32x4*)(mbase + (size_t)b * MODLD + c4), sc = *(const f32x4*)(mbase + (size_t)b * MODLD + D + c4);
        *(LAS f32x4*)(T + (b * 2) * 2048 + c4) = w * (sc + 1.0f); *(LAS f32x4*)(T + (b * 2 + 1) * 2048 + c4) = sh; }
    if (F.gw < TS) { const int row = TP + F.gw; f32x4 v[8]; sample_row_fold(X, PART, row, nsplit, F.lane, v); const float rs = row_ss(v);
        const float* mp = mbase + (size_t)(4 + F.gw) * MODLD; u32x2* hp = (u32x2*)(H + (size_t)row * D) + F.lane;
#pragma unroll
        for (int jx = 0; jx < 8; ++jx) { const int c = 4 * (F.lane + 64 * jx); const f32x4 w = *(const f32x4*)(nw + c), sh = *(const f32x4*)(mp + c), sc = *(const f32x4*)(mp + D + c);
            const f32x4 h = (v[jx] * rs) * w * (sc + 1.0f) + sh; u32x2 o; o.x = cvt_pk_bf16(h[0], h[1]); o.y = cvt_pk_bf16(h[2], h[3]); hp[64 * jx] = o; } }
    __syncthreads();
    for (int row = F.gw; row < TP; row += 2 * F.NGW) { const int rowb = row + F.NGW; const bool hasb = rowb < TP;
        const f32x4* xa = (const f32x4*)(X + (size_t)row * D) + F.lane; const f32x4* xb = (const f32x4*)(X + (size_t)(hasb ? rowb : row) * D) + F.lane; f32x4 va[8], vb[8];
#pragma unroll
        for (int jx = 0; jx < 8; ++jx) { va[jx] = xa[64 * jx]; vb[jx] = xb[64 * jx]; }
        const float ra = row_ss(va), rb = row_ss(vb);
        const LAS float* ta = T + ((row >> 11) * 2) * 2048; const LAS float* tb = T + (((hasb ? rowb : row) >> 11) * 2) * 2048;
        u32x2* ha = (u32x2*)(H + (size_t)row * D) + F.lane; u32x2* hb = (u32x2*)(H + (size_t)rowb * D) + F.lane;
#pragma unroll
        for (int jx = 0; jx < 8; ++jx) { const int c = 4 * (F.lane + 64 * jx);
            const f32x4 h = (va[jx] * ra) * *(const LAS f32x4*)(ta + c) + *(const LAS f32x4*)(ta + 2048 + c); u32x2 o; o.x = cvt_pk_bf16(h[0], h[1]); o.y = cvt_pk_bf16(h[2], h[3]); ha[64 * jx] = o;
            if (hasb) { const f32x4 g = (vb[jx] * rb) * *(const LAS f32x4*)(tb + c) + *(const LAS f32x4*)(tb + 2048 + c); u32x2 q; q.x = cvt_pk_bf16(g[0], g[1]); q.y = cvt_pk_bf16(g[2], g[3]); hb[64 * jx] = q; } }
    }
    __syncthreads();
}
__device__ __forceinline__ void phase_final(const Frame& F, int nsplit) {
    float* X = (float*)(WSP + WS_X); const float* PART = (const float*)(WSP + WS_PART); const float* fw = INP(I_FNW); float* out = OUTP + O_Y;
    if (F.gw < TS) { const int row = TP + F.gw; f32x4 v[8]; sample_row_fold(X, PART, row, nsplit, F.lane, v); const float rs = row_ss(v); f32x4* op = (f32x4*)(out + (size_t)row * D) + F.lane;
#pragma unroll
        for (int jx = 0; jx < 8; ++jx) { const f32x4 w = *(const f32x4*)(fw + 4 * (F.lane + 64 * jx)); op[64 * jx] = (v[jx] * rs) * w; } }
    for (int row = F.gw; row < TP; row += F.NGW) {
        const f32x4* xr = (const f32x4*)(X + (size_t)row * D) + F.lane; f32x4 v[8];
#pragma unroll
        for (int jx = 0; jx < 8; ++jx) v[jx] = xr[64 * jx];
        const float rs = row_ss(v); f32x4* op = (f32x4*)(out + (size_t)row * D) + F.lane;
#pragma unroll
        for (int jx = 0; jx < 8; ++jx) { const f32x4 w = *(const f32x4*)(fw + 4 * (F.lane + 64 * jx)); op[64 * jx] = (v[jx] * rs) * w; }
    }
}

__device__ __forceinline__ void s5_params(int j, int g, int n, float& ar, float& ai, float (&bbr)[16], float (&bbi)[16]) {
    const float step = expf(INP(I_LSTEP)[j * 64 + g]); const int gi = (j * 64 + g) * 64 + n;
    const float lr = INP(I_LAMRE)[gi], li = INP(I_LAMIM)[gi], mag = expf(lr * step); float sn, cs; sincos_acc(li * step, sn, cs);
    ar = mag * cs; ai = mag * sn;
    const float den = lr * lr + li * li, pr = ar - 1.0f, pim = ai, zr = (pr * lr + pim * li) / den, zi = (pim * lr - pr * li) / den;
    const f32x4* br = (const f32x4*)(INP(I_BRE) + (size_t)gi * 16); const f32x4* bi = (const f32x4*)(INP(I_BIM) + (size_t)gi * 16);
#pragma unroll
    for (int q = 0; q < 4; ++q) { const f32x4 r4 = br[q], i4 = bi[q];
#pragma unroll
        for (int e = 0; e < 4; ++e) { bbr[4 * q + e] = zr * r4[e] - zi * i4[e]; bbi[4 * q + e] = zr * i4[e] + zi * r4[e]; } }
}
__device__ __forceinline__ void s5_load_u(const bf16* Z, int row0, int g, LAS float* ut, int lane) {
    const u32x4* p = (const u32x4*)(Z + (size_t)(row0 + lane) * DIN + g * 16); const u32x4 w0 = p[0], w1 = p[1];
    LAS f32x4* o = (LAS f32x4*)(ut + lane * 16);
    o[0] = (f32x4){bflo(w0.x), bfhi(w0.x), bflo(w0.y), bfhi(w0.y)}; o[1] = (f32x4){bflo(w0.z), bfhi(w0.z), bflo(w0.w), bfhi(w0.w)};
    o[2] = (f32x4){bflo(w1.x), bfhi(w1.x), bflo(w1.y), bfhi(w1.y)}; o[3] = (f32x4){bflo(w1.z), bfhi(w1.z), bflo(w1.w), bfhi(w1.w)};
    asm volatile("s_waitcnt lgkmcnt(0)" ::: "memory");
}
#define S5_STEP(utrow) do { const LAS f32x4* _u = (const LAS f32x4*)(utrow); const f32x4 u0 = _u[0], u1 = _u[1], u2 = _u[2], u3 = _u[3]; float xr = 0.f, xi = 0.f; \
    _Pragma("unroll") for (int e = 0; e < 4; ++e) { xr = fmaf(bbr[e], u0[e], xr); xi = fmaf(bbi[e], u0[e], xi); xr = fmaf(bbr[4 + e], u1[e], xr); xi = fmaf(bbi[4 + e], u1[e], xi); \
        xr = fmaf(bbr[8 + e], u2[e], xr); xi = fmaf(bbi[8 + e], u2[e], xi); xr = fmaf(bbr[12 + e], u3[e], xr); xi = fmaf(bbi[12 + e], u3[e], xi); } \
    const float nr = fmaf(ar, hr, fmaf(-ai, hi, xr)), ni = fmaf(ar, hi, fmaf(ai, hr, xi)); hr = nr; hi = ni; } while (0)

__device__ __forceinline__ void s5_sample(const Frame& F, int j) {
    const bf16* Z = (const bf16*)(WSP + WS_Z); bf16* YA = (bf16*)(WSP + WS_YA);
    LAS float* hb = (LAS float*)(F.lds + F.wave * 4096);
    for (int item = F.vcu; item < 256; item += F.G) { const int g = item >> 2, bq = item & 3, n = F.lane;
        float ar, ai, bbr[16], bbi[16]; s5_params(j, g, n, ar, ai, bbr, bbi);
        for (int i = 0; i < 4; ++i) { const int b = bq * 32 + F.wave * 4 + i, row = TP + b;
            const u32x4* p = (const u32x4*)(Z + (size_t)row * DIN + g * 16); const u32x4 w0 = p[0], w1 = p[1];
            float u[16] = {bflo(w0.x), bfhi(w0.x), bflo(w0.y), bfhi(w0.y), bflo(w0.z), bfhi(w0.z), bflo(w0.w), bfhi(w0.w), bflo(w1.x), bfhi(w1.x), bflo(w1.y), bfhi(w1.y), bflo(w1.z), bfhi(w1.z), bflo(w1.w), bfhi(w1.w)};
            const size_t si = (size_t)((j * 128 + b) * 64 + g) * 64 + n; const float h0r = INP(I_S5RE)[si], h0i = INP(I_S5IM)[si];
            float xr = 0.f, xi = 0.f;
#pragma unroll
            for (int e = 0; e < 16; ++e) { xr = fmaf(bbr[e], u[e], xr); xi = fmaf(bbi[e], u[e], xi); }
            const float hr = ar * h0r - ai * h0i + xr, hi = ar * h0i + ai * h0r + xi;
            OUTP[O_SS5R + si] = hr; OUTP[O_SS5I + si] = hi;
            hb[n] = hr; hb[64 + n] = hi; asm volatile("s_waitcnt lgkmcnt(0)" ::: "memory");
            if (n < 16) { const float* cr = INP(I_CRE) + (size_t)((j * 64 + g) * 16 + n) * 64; const float* ci = INP(I_CIM) + (size_t)((j * 64 + g) * 16 + n) * 64; float y = 0.f;
                for (int q = 0; q < 64; ++q) y += hb[q] * cr[q] - hb[64 + q] * ci[q];
                float uk = 0.f;
#pragma unroll
                for (int e = 0; e < 16; ++e) uk = (n == e) ? u[e] : uk;
                y += INP(I_S5D)[j * 1024 + g * 16 + n] * uk;
                YA[(size_t)row * DA + g * 16 + n] = (bf16)(cvt_pk_bf16(fgelu(y), 0.f) & 0xffffu); }
            asm volatile("s_waitcnt lgkmcnt(0)" ::: "memory");
        }
    }
}
typedef short bf16x4 __attribute__((ext_vector_type(4)));
__device__ __forceinline__ void s5_disc(int j, int g, int n, float& ar, float& ai, float& zr, float& zi) {
    const float step = expf(INP(I_LSTEP)[j * 64 + g]); const int gi = (j * 64 + g) * 64 + n;
    const float lr = INP(I_LAMRE)[gi], li = INP(I_LAMIM)[gi], mag = expf(lr * step); float sn, cs; sincos_acc(li * step, sn, cs);
    ar = mag * cs; ai = mag * sn; const float den = lr * lr + li * li, pr = ar - 1.0f, pim = ai; zr = (pr * lr + pim * li) / den; zi = (pim * lr - pr * li) / den;
}
__device__ __forceinline__ void s5_fused(const Frame& F, int j) {
    unsigned char* ws = WSP; const bf16* Z = (const bf16*)(ws + WS_Z); bf16* YA = (bf16*)(ws + WS_YA);
    LAS float* X2 = (LAS float*)(F.lds + F.wave * 14592);
    LAS unsigned char* Hb = F.lds + F.wave * 14592 + 10240;
    LAS float* EX = (LAS float*)(F.lds + 8 * 14592);
    const int n = F.lane, r = F.lane & 15, kq = F.lane >> 4, c = F.wave;
    for (int item = F.vcu; item < 256; item += F.G) { const int b = item >> 6, g = item & 63, row0 = b * 2048 + c * 256;
        float ar, ai, zr0, zi0; s5_disc(j, g, n, ar, ai, zr0, zi0);
        bf16x4 bre[4], bim[4];
#pragma unroll
        for (int st = 0; st < 4; ++st) { const int ns = st * 16 + r; float a0, a1, zr, zi; s5_disc(j, g, ns, a0, a1, zr, zi); const size_t bo = (size_t)((j * 64 + g) * 64 + ns) * 16 + 4 * kq;
            const f32x4 br = *(const f32x4*)(INP(I_BRE) + bo), bi = *(const f32x4*)(INP(I_BIM) + bo); const f32x4 xr = br * zr - bi * zi, xi = bi * zr + br * zi;
            u32x2 pr; pr.x = cvt_pk_bf16(xr[0], xr[1]); pr.y = cvt_pk_bf16(xr[2], xr[3]); u32x2 pi; pi.x = cvt_pk_bf16(xi[0], xi[1]); pi.y = cvt_pk_bf16(xi[2], xi[3]);
            bre[st] = __builtin_bit_cast(bf16x4, pr); bim[st] = __builtin_bit_cast(bf16x4, pi); }
        u32x2 uf[16];
#pragma unroll
        for (int blk = 0; blk < 16; ++blk) uf[blk] = *(const u32x2*)(Z + (size_t)(row0 + blk * 16 + r) * DIN + g * 16 + 4 * kq);
        const f32x4 zero4 = (f32x4){0.f, 0.f, 0.f, 0.f};
#define S5_XBLK(blk) do { const bf16x4 ua = __builtin_bit_cast(bf16x4, uf[blk]); \
            _Pragma("unroll") for (int st = 0; st < 4; ++st) { const f32x4 xr4 = __builtin_amdgcn_mfma_f32_16x16x16bf16_1k(ua, bre[st], zero4, 0, 0, 0), xi4 = __builtin_amdgcn_mfma_f32_16x16x16bf16_1k(ua, bim[st], zero4, 0, 0, 0); \
                *(LAS f32x4*)(X2 + (st * 16 + r) * 20 + 4 * kq) = xr4; *(LAS f32x4*)(X2 + (64 + st * 16 + r) * 20 + 4 * kq) = xi4; } \
            asm volatile("s_waitcnt lgkmcnt(0)" ::: "memory"); } while (0)
        float hr = 0.f, hi = 0.f;
#pragma unroll
        for (int blk = 0; blk < 16; ++blk) { S5_XBLK(blk);
#pragma unroll
            for (int q = 0; q < 4; ++q) { const f32x4 xr4 = *(const LAS f32x4*)(X2 + n * 20 + 4 * q), xi4 = *(const LAS f32x4*)(X2 + (64 + n) * 20 + 4 * q);
#pragma unroll
                for (int e = 0; e < 4; ++e) { const float nr = fmaf(ar, hr, fmaf(-ai, hi, xr4[e])), ni = fmaf(ar, hi, fmaf(ai, hr, xi4[e])); hr = nr; hi = ni; } }
            asm volatile("s_waitcnt lgkmcnt(0)" ::: "memory"); }
        __syncthreads();
        EX[c * 128 + n] = hr; EX[c * 128 + 64 + n] = hi;
        __syncthreads();
        float pr = ar, pi = ai;
#pragma unroll
        for (int q = 0; q < 8; ++q) { const float t0 = pr * pr - pi * pi, t1 = 2.0f * pr * pi; pr = t0; pi = t1; }
        hr = 0.f; hi = 0.f;
        for (int cc = 0; cc < c; ++cc) { const float er = EX[cc * 128 + n], ei = EX[cc * 128 + 64 + n]; const float nr = pr * hr - pi * hi + er, ni = pr * hi + pi * hr + ei; hr = nr; hi = ni; }
        pg8::bf16x8 ctf[4];
#pragma unroll
        for (int ks = 0; ks < 4; ++ks) { const int np0 = ks * 32 + kq * 8; const float* src = (np0 < 64 ? INP(I_CRE) : INP(I_CIM)) + (size_t)((j * 64 + g) * 16 + r) * 64 + (np0 & 63); const float sg = np0 < 64 ? 1.0f : -1.0f;
            const f32x4 c0 = *(const f32x4*)src * sg, c1 = *(const f32x4*)(src + 4) * sg; u32x4 o; o.x = cvt_pk_bf16(c0[0], c0[1]); o.y = cvt_pk_bf16(c0[2], c0[3]); o.z = cvt_pk_bf16(c1[0], c1[1]); o.w = cvt_pk_bf16(c1[2], c1[3]); ctf[ks] = __builtin_bit_cast(pg8::bf16x8, o); }
        const f32x4 dsk = *(const f32x4*)(INP(I_S5D) + j * 1024 + g * 16 + 4 * kq);
#pragma unroll
        for (int blk = 0; blk < 16; ++blk) { S5_XBLK(blk);
#pragma unroll
            for (int q = 0; q < 4; ++q) { const f32x4 xr4 = *(const LAS f32x4*)(X2 + n * 20 + 4 * q), xi4 = *(const LAS f32x4*)(X2 + (64 + n) * 20 + 4 * q);
#pragma unroll
                for (int e = 0; e < 4; ++e) { const float nr = fmaf(ar, hr, fmaf(-ai, hi, xr4[e])), ni = fmaf(ar, hi, fmaf(ai, hr, xi4[e])); hr = nr; hi = ni;
                    const unsigned hw = cvt_pk_bf16(hr, hi); *(LAS unsigned short*)(Hb + (4 * q + e) * 272 + n * 2) = (unsigned short)(hw & 0xffffu); *(LAS unsigned short*)(Hb + (4 * q + e) * 272 + (64 + n) * 2) = (unsigned short)(hw >> 16); } }
            asm volatile("s_waitcnt lgkmcnt(0)" ::: "memory");
            f32x4 y = zero4;
#pragma unroll
            for (int ks = 0; ks < 4; ++ks) y = __builtin_amdgcn_mfma_f32_16x16x32_bf16(ctf[ks], *(const LAS pg8::bf16x8*)(Hb + r * 272 + ks * 64 + kq * 16), y, 0, 0, 0);
            y += dsk * (f32x4){bflo(uf[blk].x), bfhi(uf[blk].x), bflo(uf[blk].y), bfhi(uf[blk].y)};
            u32x2 wv; wv.x = cvt_pk_bf16(fgelu(y[0]), fgelu(y[1])); wv.y = cvt_pk_bf16(fgelu(y[2]), fgelu(y[3]));
            *(u32x2*)(YA + (size_t)(row0 + blk * 16 + r) * DA + g * 16 + 4 * kq) = wv;
            asm volatile("s_waitcnt lgkmcnt(0)" ::: "memory"); }
#undef S5_XBLK
        if (c == 7) { const size_t si = (size_t)((j * 4 + b) * 64 + g) * 64 + n; OUTP[O_PS5R + si] = hr; OUTP[O_PS5I + si] = hi; }
    }
    __syncthreads();
}

__device__ __forceinline__ pg8::bf16x8 lds_frag(const LAS unsigned char* base, int row, int stride, int kbyte) { return *(const LAS pg8::bf16x8*)(base + row * stride + kbyte); }
__device__ __forceinline__ void hgrn_h1(const Frame& F, int j) {
    unsigned char* ws = WSP; const bf16* Z = (const bf16*)(ws + WS_Z); float* OB = (float*)(ws + WS_OB); const float* LB = (const float*)(ws + WS_LB) + j * 1024;
    float* TT = (float*)(ws + WS_HT); bf16* QG = (bf16*)(ws + WS_QG); float* HD = (float*)(ws + WS_HD);
    LAS unsigned char* QT = F.lds; LAS unsigned char* KT = QT + 17408; LAS unsigned char* KHT = KT + 17408; LAS unsigned char* VT = KHT + 18432; LAS unsigned char* PT = VT + 18432; LAS float* SEG = (LAS float*)(PT + 9216);
    const int col = F.tid & 127, seg = F.tid >> 7, t0 = seg * 16, r = F.lane & 15, kq = F.lane >> 4, w = F.wave;
    for (int item = F.vcu; item < 1024; item += F.G) { const int b = item >> 8, c = (item >> 3) & 31, h = item & 7, row0 = b * 2048 + c * 64;
        const bf16* zq = Z + (size_t)(row0 + t0) * DIN + 1024 + h * 128 + col; const float lb = LB[h * 128 + col];
        float q[16], kk[16], g[16]; unsigned short vr[16];
#pragma unroll
        for (int i = 0; i < 16; ++i) { const float qv = __uint_as_float((unsigned)zq[(size_t)i * DIN] << 16), fz = __uint_as_float((unsigned)zq[(size_t)i * DIN + 1024] << 16); vr[i] = zq[(size_t)i * DIN + 2048];
            const float s = fsigmoid(fz), f = lb + (1.0f - lb) * s; q[i] = qv; kk[i] = (1.0f - lb) * (1.0f - s); g[i] = __logf(f); }
#pragma unroll
        for (int i = 1; i < 16; ++i) g[i] += g[i - 1];
        __syncthreads();
        SEG[seg * 128 + col] = g[15];
        __syncthreads();
        const float s0 = SEG[col], s1 = SEG[128 + col], s2 = SEG[256 + col], s3 = SEG[384 + col];
        const float pre = seg == 0 ? 0.f : seg == 1 ? s0 : seg == 2 ? s0 + s1 : s0 + s1 + s2, Gm = s0 + s1, Gl = (s0 + s1) + (s2 + s3);
        unsigned khb[8];
#pragma unroll
        for (int i = 0; i < 16; ++i) { const float G = pre + g[i]; const float qt = q[i] * __expf(G - Gm), kt = kk[i] * __expf(Gm - G), kh = kk[i] * __expf(Gl - G), qg = q[i] * __expf(G);
            const unsigned p0 = cvt_pk_bf16(qt, kt), p1 = cvt_pk_bf16(kh, qg);
            *(LAS unsigned short*)(QT + (t0 + i) * 272 + col * 2) = (unsigned short)(p0 & 0xffffu); *(LAS unsigned short*)(KT + (t0 + i) * 272 + col * 2) = (unsigned short)(p0 >> 16);
            QG[((size_t)item * 64 + t0 + i) * 128 + col] = (bf16)(p1 >> 16);
            if (i & 1) khb[i >> 1] |= (p1 & 0xffffu) << 16; else khb[i >> 1] = p1 & 0xffffu; }
        *(LAS u32x4*)(KHT + col * 144 + t0 * 2) = (u32x4){khb[0], khb[1], khb[2], khb[3]}; *(LAS u32x4*)(KHT + col * 144 + t0 * 2 + 16) = (u32x4){khb[4], khb[5], khb[6], khb[7]};
        *(LAS u32x4*)(VT + col * 144 + t0 * 2) = (u32x4){(unsigned)vr[0] | ((unsigned)vr[1] << 16), (unsigned)vr[2] | ((unsigned)vr[3] << 16), (unsigned)vr[4] | ((unsigned)vr[5] << 16), (unsigned)vr[6] | ((unsigned)vr[7] << 16)};
        *(LAS u32x4*)(VT + col * 144 + t0 * 2 + 16) = (u32x4){(unsigned)vr[8] | ((unsigned)vr[9] << 16), (unsigned)vr[10] | ((unsigned)vr[11] << 16), (unsigned)vr[12] | ((unsigned)vr[13] << 16), (unsigned)vr[14] | ((unsigned)vr[15] << 16)};
        if (seg == 0) HD[(size_t)item * 128 + col] = __expf(Gl);
        __syncthreads();
        { const int tt = w & 3;
#pragma unroll
          for (int u = 0; u < 2; ++u) { const int st = 2 * (w >> 2) + u; f32x4 acc = (f32x4){0.f, 0.f, 0.f, 0.f};
              if (st <= tt) {
#pragma unroll
                  for (int ks = 0; ks < 4; ++ks) acc = __builtin_amdgcn_mfma_f32_16x16x32_bf16(lds_frag(KT, st * 16 + r, 272, ks * 64 + kq * 16), lds_frag(QT, tt * 16 + r, 272, ks * 64 + kq * 16), acc, 0, 0, 0); }
              const int t = tt * 16 + r, sb = st * 16 + 4 * kq;
              u32x2 pw; pw.x = cvt_pk_bf16(sb <= t ? acc[0] : 0.f, sb + 1 <= t ? acc[1] : 0.f); pw.y = cvt_pk_bf16(sb + 2 <= t ? acc[2] : 0.f, sb + 3 <= t ? acc[3] : 0.f);
              *(LAS u32x2*)(PT + t * 144 + sb * 2) = pw; } }
        __syncthreads();
        { const int tt = w & 3; const pg8::bf16x8 p0 = lds_frag(PT, tt * 16 + r, 144, kq * 16), p1 = lds_frag(PT, tt * 16 + r, 144, 64 + kq * 16);
#pragma unroll
          for (int u = 0; u < 4; ++u) { const int vt = 4 * (w >> 2) + u; f32x4 acc = (f32x4){0.f, 0.f, 0.f, 0.f};
              acc = __builtin_amdgcn_mfma_f32_16x16x32_bf16(lds_frag(VT, vt * 16 + r, 144, kq * 16), p0, acc, 0, 0, 0); acc = __builtin_amdgcn_mfma_f32_16x16x32_bf16(lds_frag(VT, vt * 16 + r, 144, 64 + kq * 16), p1, acc, 0, 0, 0);
              *(f32x4*)(OB + (size_t)(row0 + tt * 16 + r) * 1024 + h * 128 + vt * 16 + 4 * kq) = acc; } }
        { const int vt = w; const pg8::bf16x8 v0 = lds_frag(VT, vt * 16 + r, 144, kq * 16), v1 = lds_frag(VT, vt * 16 + r, 144, 64 + kq * 16);
#pragma unroll
          for (int kt = 0; kt < 8; ++kt) { f32x4 acc = (f32x4){0.f, 0.f, 0.f, 0.f};
              acc = __builtin_amdgcn_mfma_f32_16x16x32_bf16(lds_frag(KHT, kt * 16 + r, 144, kq * 16), v0, acc, 0, 0, 0); acc = __builtin_amdgcn_mfma_f32_16x16x32_bf16(lds_frag(KHT, kt * 16 + r, 144, 64 + kq * 16), v1, acc, 0, 0, 0);
              *(f32x4*)(TT + ((size_t)item * 128 + vt * 16 + r) * 128 + kt * 16 + 4 * kq) = acc; } }
    }
    __syncthreads();
}
__device__ __forceinline__ void hgrn_h2(const Frame& F, int j) {
    unsigned char* ws = WSP; const float* TT = (const float*)(ws + WS_HT); const float* HD = (const float*)(ws + WS_HD); bf16* HS = (bf16*)(ws + WS_HS);
    for (int e = F.gt; e < 32 * 128 * 32; e += F.NT) { const int bh = e >> 12, v = (e >> 5) & 127, k4 = (e & 31) * 4, b = bh >> 3, h = bh & 7;
        f32x4 S = (f32x4){0.f, 0.f, 0.f, 0.f};
#pragma unroll 4
        for (int c = 0; c < 32; ++c) { const size_t item = (size_t)(b * 32 + c) * 8 + h; const size_t o = (item * 128 + v) * 128 + k4;
            u32x2 sw; sw.x = cvt_pk_bf16(S[0], S[1]); sw.y = cvt_pk_bf16(S[2], S[3]); *(u32x2*)(HS + o) = sw;
            const f32x4 T = *(const f32x4*)(TT + o), Dv = *(const f32x4*)(HD + item * 128 + k4); S = Dv * S + T; }
        float* op = OUTP + O_PHG + ((size_t)((j * 4 + b) * 8 + h) * 128 + k4) * 128 + v;
#pragma unroll
        for (int q = 0; q < 4; ++q) op[(size_t)q * 128] = S[q]; }
}
__device__ __forceinline__ void hgrn_h3(const Frame& F, int j) {
    unsigned char* ws = WSP; const bf16* Z = (const bf16*)(ws + WS_Z); bf16* MIX = (bf16*)(ws + WS_MIX); const float* OB = (const float*)(ws + WS_OB); const bf16* QG = (const bf16*)(ws + WS_QG); const bf16* HS = (const bf16*)(ws + WS_HS);
    const int half = F.wave >> 2, tt = F.wave & 3, r = F.lane & 15, kq = F.lane >> 4;
    for (int it2 = F.vcu * 2; it2 < 1024; it2 += 2 * F.G) { const int item = it2 + half, b = item >> 8, c = (item >> 3) & 31, h = item & 7, row = b * 2048 + c * 64 + tt * 16 + r;
        pg8::bf16x8 qf[4];
#pragma unroll
        for (int ks = 0; ks < 4; ++ks) qf[ks] = *(const pg8::bf16x8*)(QG + ((size_t)item * 64 + tt * 16 + r) * 128 + ks * 32 + kq * 8);
        f32x4 o[8]; float ss = 0.f;
#pragma unroll
        for (int vt = 0; vt < 8; ++vt) { f32x4 acc = *(const f32x4*)(OB + (size_t)row * 1024 + h * 128 + vt * 16 + 4 * kq);
#pragma unroll
            for (int ks = 0; ks < 4; ++ks) acc = __builtin_amdgcn_mfma_f32_16x16x32_bf16(*(const pg8::bf16x8*)(HS + ((size_t)item * 128 + vt * 16 + r) * 128 + ks * 32 + kq * 8), qf[ks], acc, 0, 0, 0);
            o[vt] = acc; ss += (acc[0] * acc[0] + acc[1] * acc[1]) + (acc[2] * acc[2] + acc[3] * acc[3]); }
        ss += swz_xor16(ss); ss += __int_as_float(__builtin_amdgcn_ds_bpermute((F.lane ^ 32) << 2, __float_as_int(ss)));
        const float rs = 1.0f / sqrtf(ss * (1.0f / 128.0f) + EPS);
#pragma unroll
        for (int vt = 0; vt < 8; ++vt) { const int cv = h * 128 + vt * 16 + 4 * kq; const u32x2 gv = *(const u32x2*)(Z + (size_t)row * DIN + 4096 + cv); const f32x4 gw = *(const f32x4*)(INP(I_HGNW) + j * 128 + vt * 16 + 4 * kq);
            u32x2 y; y.x = cvt_pk_bf16(o[vt][0] * rs * gw[0] * fsilu(bflo(gv.x)), o[vt][1] * rs * gw[1] * fsilu(bfhi(gv.x))); y.y = cvt_pk_bf16(o[vt][2] * rs * gw[2] * fsilu(bflo(gv.y)), o[vt][3] * rs * gw[3] * fsilu(bfhi(gv.y)));
            *(u32x2*)(MIX + (size_t)row * D + 1024 + cv) = y; }
    }
}
__device__ __forceinline__ void hgrn_sample(const Frame& F, int j) {
    const bf16* Z = (const bf16*)(WSP + WS_Z); bf16* MIX = (bf16*)(WSP + WS_MIX); const float* LB = (const float*)(WSP + WS_LB) + j * 1024;
    LAS float* fb = (LAS float*)F.lds; LAS float* kb = fb + 128; LAS float* qb = kb + 128; LAS float* vb = qb + 128; LAS float* gb = vb + 128; LAS float* red = gb + 128; LAS float* POL = red + 128;
    const int tid = F.tid, v4 = (tid & 31) * 4, kq = tid >> 5;
    for (int item = F.vcu; item < 1024; item += F.G) { const int b = item >> 3, h = item & 7, row = TP + b;
        __syncthreads();
        if (tid < 128) { const bf16* zr = Z + (size_t)row * DIN + h * 128 + tid; const float lb = LB[h * 128 + tid];
            const float q = __uint_as_float((unsigned)zr[1024] << 16), fz = __uint_as_float((unsigned)zr[2048] << 16), iv = __uint_as_float((unsigned)zr[3072] << 16), g = __uint_as_float((unsigned)zr[4096] << 16);
            const float s = fsigmoid(fz); fb[tid] = lb + (1.0f - lb) * s; kb[tid] = (1.0f - lb) * (1.0f - s); qb[tid] = q; vb[tid] = iv; gb[tid] = g; }
        __syncthreads();
        const f32x4 vv = *(const LAS f32x4*)(vb + v4); f32x4 po = (f32x4){0.f, 0.f, 0.f, 0.f};
        const size_t sbase = (size_t)((j * 128 + b) * 8 + h) * 128 * 128;
#pragma unroll
        for (int i = 0; i < 8; ++i) { const int k = kq + 16 * i; const f32x4 s0 = *(const f32x4*)(INP(I_HG) + sbase + (size_t)k * 128 + v4);
            const f32x4 s1 = s0 * fb[k] + vv * kb[k]; *(f32x4*)(OUTP + O_SHG + sbase + (size_t)k * 128 + v4) = s1; po += s1 * qb[k]; }
        *(LAS f32x4*)(POL + kq * 128 + v4) = po;
        __syncthreads();
        float o = 0.f;
        if (tid < 128) {
#pragma unroll
            for (int i = 0; i < 16; ++i) o += POL[i * 128 + tid];
            const float ss = wave_sum(o * o); if (F.lane == 0) red[F.wave] = ss; }
        __syncthreads();
        if (tid < 128) { const float rs = 1.0f / sqrtf((red[0] + red[1]) * (1.0f / 128.0f) + EPS); const float y = o * rs * INP(I_HGNW)[j * 128 + tid] * fsilu(gb[tid]);
            MIX[(size_t)row * D + 1024 + h * 128 + tid] = (bf16)(cvt_pk_bf16(y, 0.f) & 0xffffu); }
    }
    __syncthreads();
}
__device__ __forceinline__ void lru_conv(const Frame& F, int j) {
    const float* XR = (const float*)(WSP + WS_XR); float* XC = (float*)(WSP + WS_XC); bf16* XCB = (bf16*)(WSP + WS_XCB);
    const float* cw = INP(I_CONVW) + (size_t)j * 4 * DRNN; const float* cb = INP(I_CONVB) + (size_t)j * DRNN;
    for (int i = F.gt; i < TT * 640; i += F.NT) { const int row = i / 640, c4 = (i % 640) * 4;
        const f32x4 w0 = *(const f32x4*)(cw + c4), w1 = *(const f32x4*)(cw + DRNN + c4), w2 = *(const f32x4*)(cw + 2 * DRNN + c4), w3 = *(const f32x4*)(cw + 3 * DRNN + c4);
        const f32x4 x3 = *(const f32x4*)(XR + (size_t)row * DRNN + c4); f32x4 x0, x1, x2; const f32x4 zero = (f32x4){0.f, 0.f, 0.f, 0.f};
        if (row < TP) { const int t = row & 2047, b = row >> 11;
            x2 = t >= 1 ? *(const f32x4*)(XR + (size_t)(row - 1) * DRNN + c4) : zero; x1 = t >= 2 ? *(const f32x4*)(XR + (size_t)(row - 2) * DRNN + c4) : zero; x0 = t >= 3 ? *(const f32x4*)(XR + (size_t)(row - 3) * DRNN + c4) : zero;
            if (t >= 2045) *(f32x4*)(OUTP + O_PCONV + (size_t)((j * 4 + b) * 3 + (t - 2045)) * DRNN + c4) = x3;
        } else { const int b = row - TP; const float* cbuf = INP(I_CONV) + (size_t)(j * 128 + b) * 3 * DRNN + c4;
            x0 = *(const f32x4*)cbuf; x1 = *(const f32x4*)(cbuf + DRNN); x2 = *(const f32x4*)(cbuf + 2 * DRNN);
            float* ob = OUTP + O_SCONV + (size_t)(j * 128 + b) * 3 * DRNN + c4; *(f32x4*)ob = x1; *(f32x4*)(ob + DRNN) = x2; *(f32x4*)(ob + 2 * DRNN) = x3; }
        const f32x4 xc = *(const f32x4*)(cb + c4) + x0 * w0 + x1 * w1 + x2 * w2 + x3 * w3;
        *(f32x4*)(XC + (size_t)row * DRNN + c4) = xc; u32x2 w; w.x = cvt_pk_bf16(xc[0], xc[1]); w.y = cvt_pk_bf16(xc[2], xc[3]); *(u32x2*)(XCB + (size_t)row * DRNN + c4) = w; }
}
__device__ __forceinline__ void lru_scan1(const Frame& F) {
    const unsigned* AB = (const unsigned*)(WSP + WS_AA); float* P = (float*)(WSP + WS_LRUP);
    for (int i = F.gt; i < 4 * 16 * 1280; i += F.NT) { const int cp = i % 1280, bc = i / 1280; const size_t base = (size_t)(bc * 128) * DRNN + 2 * cp;
        f32x2 L = (f32x2){0.f, 0.f}, Bv = (f32x2){0.f, 0.f};
#pragma unroll 8
        for (int t = 0; t < 128; ++t) { const u32x2 w = *(const u32x2*)(AB + base + (size_t)t * DRNN); const f32x2 la = (f32x2){bflo(w.x), bflo(w.y)}, bv = (f32x2){bfhi(w.x), bfhi(w.y)};
            L += la; Bv = (f32x2){__expf(la[0]), __expf(la[1])} * Bv + bv; }
        *(f32x4*)(P + (size_t)i * 4) = (f32x4){__expf(L[0]), __expf(L[1]), Bv[0], Bv[1]}; }
}
__device__ __forceinline__ void lru_scan2(const Frame& F, int j) {
    const unsigned* AB = (const unsigned*)(WSP + WS_AA); const float* P = (const float*)(WSP + WS_LRUP);
    const bf16* GB = (const bf16*)(WSP + WS_Z); bf16* MIX = (bf16*)(WSP + WS_MIX);
    for (int i = F.gt; i < 4 * 16 * 1280; i += F.NT) { const int cp = i % 1280, bc = i / 1280, c = bc & 15, b = bc >> 4; const size_t base = (size_t)(bc * 128) * DRNN + 2 * cp;
        f32x2 h = (f32x2){0.f, 0.f};
        for (int cc = 0; cc < c; ++cc) { const f32x4 pv = *(const f32x4*)(P + (size_t)((b * 16 + cc) * 1280 + cp) * 4); h = (f32x2){pv[0], pv[1]} * h + (f32x2){pv[2], pv[3]}; }
#pragma unroll 8
        for (int t = 0; t < 128; ++t) { const size_t o = base + (size_t)t * DRNN; const u32x2 w = *(const u32x2*)(AB + o); const unsigned gw = *(const unsigned*)(GB + o);
            h = (f32x2){__expf(bflo(w.x)), __expf(bflo(w.y))} * h + (f32x2){bfhi(w.x), bfhi(w.y)}; *(unsigned*)(MIX + o) = cvt_pk_bf16(bflo(gw) * h[0], bfhi(gw) * h[1]); }
        if (c == 15) *(f32x2*)(OUTP + O_PLRU + (size_t)(j * 4 + b) * DRNN + 2 * cp) = h; }
    for (int i = F.gt; i < TS * 1280; i += F.NT) { const int cp = i % 1280, b = i / 1280; const size_t o = (size_t)(TP + b) * DRNN + 2 * cp;
        const u32x2 w = *(const u32x2*)(AB + o); const f32x2 h0 = *(const f32x2*)(INP(I_LRU) + (size_t)(j * 128 + b) * DRNN + 2 * cp); const unsigned gw = *(const unsigned*)(GB + o);
        const f32x2 h = (f32x2){__expf(bflo(w.x)), __expf(bflo(w.y))} * h0 + (f32x2){bfhi(w.x), bfhi(w.y)}; *(f32x2*)(OUTP + O_SLRU + (size_t)(j * 128 + b) * DRNN + 2 * cp) = h; *(unsigned*)(MIX + o) = cvt_pk_bf16(bflo(gw) * h[0], bfhi(gw) * h[1]); }
}

#define GEMM_CALL(EpiT, OrdT, E, Aptr, Bptr, LDA, LDB, KK, NM, NN) do { pg8::Gemm g_{(const pg8::bf16_t*)(Aptr), (const pg8::bf16_t*)(Bptr), (LDA), (LDB), (KK)}; OrdT S_; S_.init((NM), (NN), F.G, F.bx); \
    pg8::gemm_phase<EpiT, OrdT, false, true>(F.lds, g_, S_, (E), F.tid); } while (0)
#define GEMM_RES(MODP, SCALE, Aptr, Bptr, LDK, NSPL) do { { EpiRes E{(float*)(ws + WS_X), (MODP), (SCALE)}; GEMM_CALL(EpiRes, pg8::StaticOrder, E, Aptr, Bptr, LDK, LDK, LDK, 32, 8); } \
    { EpiResPart E2{(float*)(ws + WS_PART), (MODP), (SCALE)}; pg8::Gemm g_{(const pg8::bf16_t*)(Aptr), (const pg8::bf16_t*)(Bptr), (LDK), (LDK), (LDK) / (NSPL)}; pg8::SplitKOrder S_; S_.init(32, 8, (NSPL), (LDK) / (NSPL), F.G, F.bx); \
      pg8::gemm_phase<EpiResPart, pg8::SplitKOrder, true, true>(F.lds, g_, S_, E2, F.tid); } } while (0)
__device__ __forceinline__ Frame make_frame(LAS unsigned char* lds, int wid) {
    Frame F; F.lds = lds; int ln = (int)__builtin_amdgcn_mbcnt_hi(~0u, __builtin_amdgcn_mbcnt_lo(~0u, 0u)); asm volatile("" : "+v"(ln)); int bx = blockIdx.x; asm volatile("" : "+s"(bx));
    F.lane = ln; F.wave = wid; F.tid = wid * 64 + ln; F.G = gridDim.x; F.bx = bx;
    F.vcu = (F.G % 8 == 0) ? (bx % 8) * (F.G / 8) + bx / 8 : bx;
    F.gw = F.vcu * NWAVES + F.wave; F.NGW = F.G * NWAVES; F.gt = F.vcu * NTHR + F.tid; F.NT = F.G * NTHR; return F;
}
__global__ void __launch_bounds__(NTHR, 2) fwd_kernel(Args a_unused) {
    extern __shared__ __attribute__((aligned(16))) unsigned char lds_raw[];
    LAS unsigned char* const lds = (LAS unsigned char*)lds_raw;
    volatile LAS unsigned* MISC = (volatile LAS unsigned*)(lds + MISC_OFF);
    for (int u = threadIdx.x; u < (LDS_BYTES - 131072) / 4; u += NTHR) ((LAS unsigned*)(lds + 131072))[u] = 0u;
    __syncthreads();
    int wid0 = __builtin_amdgcn_readfirstlane((int)threadIdx.x >> 6); asm volatile("" : "+s"(wid0)); const int wid = wid0;
    XcdBarrier bar = xcd_barrier_post((unsigned*)(WSP + WS_CTL) + CW_BAR, MISC + 8, wid);
    const int lo = (int)(unsigned)kargs()[N_IN + 2], hi = (int)(unsigned)(kargs()[N_IN + 2] >> 32); int ph = 0;
#define PH_BEGIN if (ph >= lo && ph < hi) { const Frame F = make_frame(lds, wid); unsigned char* const ws = WSP;
#define PH_END } if (ph >= lo && ph + 1 < hi) xcd_barrier(bar); ++ph;

    PH_BEGIN phase_prologue(F); PH_END
    PH_BEGIN phase_ada_conv(F); PH_END

    for (int l = 0; l < 4; ++l) {
        const int j = l >> 1;
#define MODL ((const float*)(ws + WS_MOD) + (size_t)l * NMODW)
        for (int s = 0; s < 2; ++s) {
            if (s == 1) {
                PH_BEGIN phase_norm(F, l, 1, 7); PH_END
                if ((l & 1) == 0) {
                    PH_BEGIN { EpiBf16 E{(bf16*)(ws + WS_Z), DIN}; GEMM_CALL(EpiBf16, pg8::StaticOrder, E, ws + WS_H, ws + WS_WINAB + (size_t)j * 5120 * 2048 * 2, 2048, 2048, 2048, NPAN, 20); conv_slot(F, l, 1, 148); } PH_END
                    PH_BEGIN s5_sample(F, j); __syncthreads(); hgrn_h1(F, j); hgrn_sample(F, j); PH_END
                    PH_BEGIN hgrn_h2(F, j); s5_fused(F, j); PH_END
                    PH_BEGIN hgrn_h3(F, j); PH_END
                    PH_BEGIN { EpiGlu E{(bf16*)(ws + WS_MIX), (const bf16*)(ws + WS_YA), INP(I_BGLU) + j * 1024}; GEMM_CALL(EpiGlu, pg8::StaticOrder, E, ws + WS_YA, ws + WS_WGLU + (size_t)j * 1024 * 1024 * 2, 1024, 1024, 1024, NPAN, 4); } PH_END
                    PH_BEGIN GEMM_RES(MODL + 5 * D, 1.0f, ws + WS_MIX, ws + WS_WOUTAB + (size_t)j * 2048 * 2048 * 2, 2048, 4); PH_END
                } else {
                    PH_BEGIN { EpiInC E{(bf16*)(ws + WS_Z), (float*)(ws + WS_XR)}; GEMM_CALL(EpiInC, pg8::StaticOrder, E, ws + WS_H, ws + WS_WINC + (size_t)j * 5120 * 2048 * 2, 2048, 2048, 2048, NPAN, 20); conv_slot(F, l, 1, 148); } PH_END
                    PH_BEGIN lru_conv(F, j); PH_END
                    PH_BEGIN { EpiGate E{(unsigned*)(ws + WS_AA), (const float*)(ws + WS_XC), INP(I_BGA) + j * DRNN, INP(I_BGX) + j * DRNN, (const float*)(ws + WS_LL) + j * DRNN};
                               GEMM_CALL(EpiGate, pg8::GateOrder, E, ws + WS_XCB, ws + WS_WGATE + (size_t)j * 5120 * 2560 * 2, 2560, 2560, 384, NPAN, 20); } PH_END
                    PH_BEGIN lru_scan1(F); PH_END
                    PH_BEGIN lru_scan2(F, j); PH_END
                    PH_BEGIN GEMM_RES(MODL + 5 * D, 1.0f, ws + WS_MIX, ws + WS_WOUTC + (size_t)j * 2048 * 2560 * 2, 2560, 5); PH_END
                }
            }
            PH_BEGIN phase_norm(F, l, s == 0 ? 0 : 2, s == 0 ? (l == 0 ? 0 : 7) : ((l & 1) ? 5 : 4)); PH_END
            PH_BEGIN { EpiGU E{(bf16*)(ws + WS_HID)}; GEMM_CALL(EpiGU, pg8::StaticOrder, E, ws + WS_H, ws + WS_WGU + (size_t)(l * 2 + s) * 10752 * 2048 * 2, 2048, 2048, 2048, NPAN, 42); conv_slot(F, l, s == 0 ? 0 : 2, 106); } PH_END
            PH_BEGIN GEMM_RES(MODL + (s == 0 ? 2 : 8) * D, 0.5f, ws + WS_HID, ws + WS_WD + (size_t)(l * 2 + s) * 2048 * 5376 * 2, 5376, 7); PH_END
        }
    }
    PH_BEGIN phase_final(F, 7); PH_END
}
constexpr int N_PHASES = 2 + 4 * (3 + 1 + 3) + 2 * 6 + 2 * 6 + 1;

extern "C" void kernel_launch(void* const* d_in, const int* in_sizes, int n_in, void* d_out, int out_size, void* d_ws, size_t ws_size, hipStream_t stream) {
    static int grid = 0;
    if (grid == 0) {
        if (n_in != N_IN || (size_t)out_size != O_END || ws_size < WS_END) { fprintf(stderr, "kernel_launch: unexpected shapes: n_in %d out %d ws %zu (need %zu)\n", n_in, out_size, ws_size, (size_t)WS_END); grid = -1; return; }
        int dev = 0, cus = 0, per_cu = 0;
        if (hipGetDevice(&dev) != hipSuccess || hipDeviceGetAttribute(&cus, hipDeviceAttributeMultiprocessorCount, dev) != hipSuccess) { grid = -1; return; }
        if (hipFuncSetAttribute((const void*)fwd_kernel, hipFuncAttributeMaxDynamicSharedMemorySize, LDS_BYTES) != hipSuccess) { fprintf(stderr, "kernel_launch: hipFuncSetAttribute failed\n"); grid = -1; return; }
        if (hipOccupancyMaxActiveBlocksPerMultiprocessor(&per_cu, (const void*)fwd_kernel, NTHR, LDS_BYTES) != hipSuccess || per_cu < 1) { fprintf(stderr, "kernel_launch: occupancy query says %d\n", per_cu); }
        (void)hipGetLastError();
        grid = cus;
    }
    if (grid < 0) return;
    (void)hipMemsetAsync((char*)d_ws + WS_CTL, 0, CTL_BYTES, stream);
    Args a{};
    for (int i = 0; i < N_IN; ++i) a.in[i] = (const float*)d_in[i];
    a.out = (float*)d_out; a.ws = (unsigned char*)d_ws;
#ifndef MK_PER_PHASE
    a.lo = 0; a.hi = N_PHASES;
    hipLaunchKernelGGL(fwd_kernel, dim3(grid), dim3(NTHR), LDS_BYTES, stream, a);
#else
    for (int p = 0; p < N_PHASES; ++p) { a.lo = p; a.hi = p + 1; hipLaunchKernelGGL(fwd_kernel, dim3(grid), dim3(NTHR), LDS_BYTES, stream, a); }
#endif
}
```

```cpp
#include <hip/hip_runtime.h>
#include <cstdio>
#include <cstdint>

namespace pg8 {
#define PG8_LAS __attribute__((address_space(3)))
typedef unsigned short bf16_t;
typedef short bf16x8 __attribute__((ext_vector_type(8)));
typedef float f32x4 __attribute__((ext_vector_type(4)));
typedef unsigned u32x4 __attribute__((ext_vector_type(4)));
constexpr int BM = 256, BK = 64, HALF = 128, HTB = HALF * BK * 2  , STAGE_BYTES = 8 * HTB, NXCD = 8, WGM = 8;

__host__ __device__ __forceinline__ int lds_byte(int r, int c) { const int st = (r >> 4) * 2 + (c >> 5), rr = r & 15, cc = c & 31, ob = rr * 64 + cc * 2; return st * 1024 + (ob ^ (((ob >> 9) & 1) << 5)); }
__host__ __device__ __forceinline__ void stage_rc(int b, int& R, int& C) { const int st = b / 1024, sb = b % 1024, swz = sb ^ (((sb >> 9) & 1) << 5); R = (st >> 1) * 16 + swz / 64; C = (st & 1) * 32 + (swz % 64) / 2; }
__host__ __device__ __forceinline__ int perm32(int rho) { const int n = rho >> 4, i = rho & 15; return 8 * (i >> 2) + 4 * n + (i & 3); }

struct Unit { int pm, pn, ks; };
struct Gemm { const bf16_t* A; const bf16_t* Bt; int lda, ldb, K; };

struct StaticOrder {
    int nM, nN, nwg, G, c;
    __host__ __device__ void init(int nM_, int nN_, int G_, int c_) { nM = nM_; nN = nN_; nwg = nM * nN; G = G_; c = c_; }
    __host__ __device__ bool next(int i, Unit& u) const {
        const long L = (long)i * G + c; if (L >= nwg) return false;
        int wgid = (int)L; { const int q = nwg / NXCD, r = nwg % NXCD, xcd = wgid % NXCD, off = wgid / NXCD; wgid = (xcd < r ? xcd * (q + 1) : r * (q + 1) + (xcd - r) * q) + off; }
        const int nig = WGM * nN, gid = wgid / nig, fm = gid * WGM, gsz = (nM - fm) < WGM ? (nM - fm) : WGM;
        u.pm = fm + ((wgid % nig) % gsz); u.pn = (wgid % nig) / gsz; u.ks = 0; return true;
    }
    __device__ __forceinline__ int koff(const Unit&) const { return 0; }
    __device__ __forceinline__ int koffB(const Unit&) const { return 0; }
    __device__ __forceinline__ void a_ready(const Unit&) const {}
    __device__ __forceinline__ void done(const Unit&) const {}
};
struct GateOrder : StaticOrder {
    __device__ __forceinline__ int koff(const Unit& u) const { const int k0 = ((u.pn * 128) / 160) * 160; return k0 < 2176 ? k0 : 2176; }
    __device__ __forceinline__ int koffB(const Unit& u) const { return koff(u); }
};

struct SplitKOrder {
    int pm, nN, nwg, G, c, klen;
    __host__ __device__ void init(int pm_, int nN_, int nK_, int klen_, int G_, int c_) { pm = pm_; nN = nN_; nwg = nN_ * nK_; klen = klen_; G = G_; c = c_; }
    __host__ __device__ bool next(int i, Unit& u) const { const long L = (long)i * G + c; if (L >= nwg) return false; u.pm = pm; u.pn = (int)L % nN; u.ks = (int)L / nN; return true; }
    __device__ __forceinline__ int koff(const Unit& u) const { return u.ks * klen; }
    __device__ __forceinline__ int koffB(const Unit& u) const { return u.ks * klen; }
    __device__ __forceinline__ void a_ready(const Unit&) const {}
    __device__ __forceinline__ void done(const Unit&) const {}
};

__device__ __forceinline__ unsigned cvt_pk_bf16(float lo, float hi) { unsigned r; asm volatile("v_cvt_pk_bf16_f32 %0, %1, %2" : "=v"(r) : "v"(lo), "v"(hi)); return r; }

template <class Epi, class Sched, bool ALIGN_EPI = false, bool SP2 = false>
__device__ __forceinline__ void gemm_phase(PG8_LAS unsigned char* lds, const Gemm g, const Sched& S, const Epi& E, const int tid_in) {
    int tid_ = tid_in; asm volatile("" : "+v"(tid_));
    const int tid = tid_, wid = __builtin_amdgcn_readfirstlane(tid >> 6), lane = tid & 63, wr = wid >> 2, wc = wid & 3, fr = lane & 15, fq = lane >> 4;
    const int K = g.K, nt = K / BK;
    unsigned voffA[2], voffB[2];
#pragma unroll
    for (int i = 0; i < 2; ++i) { int R, C; stage_rc(tid * 16 + i * 8192, R, C); const int Rb = Epi::PERM ? ((R & ~31) + perm32(R & 31)) : R;
        voffA[i] = (unsigned)(R * g.lda + C) * 2u; voffB[i] = (unsigned)(Rb * g.ldb + C) * 2u; }
    const size_t kstep = (size_t)(BK * 2);
    const size_t hstepA = (size_t)HALF * g.lda * 2, hstepB = (size_t)HALF * g.ldb * 2;
    const size_t tstepA = 2 * hstepA, tstepB = 2 * hstepB;
    const unsigned ldsw = (unsigned)wid * 1024u;
    const int aoff = lds_byte(wr * 64 + fr, fq * 8), boff = lds_byte(wc * 32 + fr, fq * 8);
#define PG8_SA(b, h) (((b) * 2 + (h)) * HTB)
#define PG8_SB(b, h) ((4 + (b) * 2 + (h)) * HTB)
#define PG8_STAGE(bufoff, gbase, voff) do { _Pragma("unroll") for (int _i = 0; _i < 2; ++_i) \
        __builtin_amdgcn_global_load_lds((const unsigned*)((const char*)(gbase) + (voff)[_i]), (PG8_LAS unsigned*)(lds + (bufoff) + ldsw + _i * 8192), 16, 0, 0); } while (0)
#define PG8_LDA(dst, b, h) do { _Pragma("unroll") for (int m = 0; m < 4; ++m) _Pragma("unroll") for (int k = 0; k < 2; ++k) dst[m][k] = *(const PG8_LAS bf16x8*)(lds + PG8_SA(b, h) + aoff + m * 2048 + k * 1024); } while (0)
#define PG8_LDB(dst, b, h) do { _Pragma("unroll") for (int n = 0; n < 2; ++n) _Pragma("unroll") for (int k = 0; k < 2; ++k) dst[n][k] = *(const PG8_LAS bf16x8*)(lds + PG8_SB(b, h) + boff + n * 2048 + k * 1024); } while (0)
#define PG8_MMA(ai, bj, At, Bt) do { __builtin_amdgcn_s_setprio(1); _Pragma("unroll") for (int m = 0; m < 4; ++m) _Pragma("unroll") for (int n = 0; n < 2; ++n) _Pragma("unroll") for (int k = 0; k < 2; ++k) \
        acc[ai][bj][m][n] = __builtin_amdgcn_mfma_f32_16x16x32_bf16(Bt[n][k], At[m][k], acc[ai][bj][m][n], 0, 0, 0); __builtin_amdgcn_s_setprio(0); } while (0)
#define PG8_WAIT_V(n) asm volatile("s_waitcnt vmcnt(" #n ")" ::: "memory")
#define PG8_WAIT_L(n) asm volatile("s_waitcnt lgkmcnt(" #n ")" ::: "memory")
#define PG8_BAR __builtin_amdgcn_s_barrier()
#define PG8_SCHED __builtin_amdgcn_sched_barrier(0)
    Unit cur, nxt; int ui = 0;
    if (!S.next(0, cur)) return;
    f32x4 acc[2][2][4][2];
#pragma unroll
    for (int a = 0; a < 2; ++a)
#pragma unroll
        for (int b = 0; b < 2; ++b)
#pragma unroll
            for (int m = 0; m < 4; ++m)
#pragma unroll
                for (int n = 0; n < 2; ++n) acc[a][b][m][n] = (f32x4){0.f, 0.f, 0.f, 0.f};
    bf16x8 At[4][2], B0[2][2], B1[2][2];
    const char* cA = (const char*)g.A + (size_t)cur.pm * tstepA + (size_t)S.koff(cur) * 2; const char* cB = (const char*)g.Bt + (size_t)cur.pn * tstepB + (size_t)S.koffB(cur) * 2;
    S.a_ready(cur);
    if constexpr (SP2) {
        PG8_STAGE(PG8_SB(0, 0), cB, voffB); PG8_STAGE(PG8_SB(0, 1), cB + hstepB, voffB); PG8_STAGE(PG8_SA(0, 0), cA, voffA); PG8_STAGE(PG8_SA(0, 1), cA + hstepA, voffA);
        if (wr == 1) PG8_BAR;
        PG8_WAIT_V(2); PG8_BAR;
        PG8_STAGE(PG8_SB(1, 0), cB + kstep, voffB); PG8_STAGE(PG8_SA(1, 0), cA + kstep, voffA); PG8_STAGE(PG8_SB(1, 1), cB + hstepB + kstep, voffB);
        PG8_WAIT_V(6); PG8_BAR;
    } else {
        PG8_STAGE(PG8_SB(0, 0), cB, voffB); PG8_STAGE(PG8_SA(0, 0), cA, voffA); PG8_STAGE(PG8_SB(0, 1), cB + hstepB, voffB); PG8_STAGE(PG8_SA(0, 1), cA + hstepA, voffA);
        if (wr == 1) PG8_BAR;
        PG8_WAIT_V(4); PG8_BAR;
        PG8_STAGE(PG8_SB(1, 0), cB + kstep, voffB); PG8_STAGE(PG8_SA(1, 0), cA + kstep, voffA); PG8_STAGE(PG8_SB(1, 1), cB + hstepB + kstep, voffB);
        PG8_WAIT_V(6); PG8_BAR;
    }
    for (;;) {
        const bool has_next = S.next(ui + 1, nxt);
        const char* nA = has_next ? (const char*)g.A + (size_t)nxt.pm * tstepA + (size_t)S.koff(nxt) * 2 : cA; const char* nB = has_next ? (const char*)g.Bt + (size_t)nxt.pn * tstepB + (size_t)S.koffB(nxt) * 2 : cB;
#pragma unroll 1
        for (int t = 0; t < nt; t += 2) {
            const bool last = (t == nt - 2);
            const char* a1 = cA + (size_t)(t + 1) * kstep;
            const char* a2 = last ? nA : cA + (size_t)(t + 2) * kstep; const char* b2 = last ? nB : cB + (size_t)(t + 2) * kstep;
            const char* a3 = a2 + kstep; const char* b3 = b2 + kstep;
            if (last && has_next) S.a_ready(nxt);
            if constexpr (SP2) {
            PG8_LDB(B0, 0, 0); PG8_LDB(B1, 0, 1); PG8_SCHED; PG8_LDA(At, 0, 0); PG8_STAGE(PG8_SA(1, 1), a1 + hstepA, voffA);
            PG8_WAIT_V(8); PG8_WAIT_L(0); PG8_BAR; PG8_MMA(0, 0, At, B0); PG8_MMA(0, 1, At, B1); PG8_BAR; PG8_SCHED;
            PG8_LDA(At, 0, 1); PG8_STAGE(PG8_SB(0, 0), b2, voffB); PG8_STAGE(PG8_SB(0, 1), b2 + hstepB, voffB); PG8_STAGE(PG8_SA(0, 0), a2, voffA);
            PG8_WAIT_V(8); PG8_WAIT_L(0); PG8_BAR; PG8_MMA(1, 0, At, B0); PG8_MMA(1, 1, At, B1); PG8_BAR; PG8_SCHED;
            PG8_LDB(B0, 1, 0); PG8_LDB(B1, 1, 1); PG8_SCHED; PG8_LDA(At, 1, 0); PG8_STAGE(PG8_SA(0, 1), a2 + hstepA, voffA);
            PG8_WAIT_V(8); PG8_WAIT_L(0); PG8_BAR; PG8_MMA(0, 0, At, B0); PG8_MMA(0, 1, At, B1); PG8_BAR; PG8_SCHED;
            PG8_LDA(At, 1, 1); PG8_STAGE(PG8_SB(1, 0), b3, voffB); PG8_STAGE(PG8_SB(1, 1), b3 + hstepB, voffB); PG8_STAGE(PG8_SA(1, 0), a3, voffA);
            PG8_WAIT_V(8); PG8_WAIT_L(0); PG8_BAR; PG8_MMA(1, 0, At, B0); PG8_MMA(1, 1, At, B1); PG8_BAR; PG8_SCHED;
            } else {
            PG8_LDB(B0, 0, 0); PG8_SCHED; PG8_LDA(At, 0, 0); PG8_STAGE(PG8_SA(1, 1), a1 + hstepA, voffA);
            PG8_WAIT_L(8); PG8_BAR; PG8_WAIT_L(0); PG8_MMA(0, 0, At, B0); PG8_BAR; PG8_SCHED;
            PG8_LDB(B1, 0, 1); PG8_STAGE(PG8_SB(0, 0), b2, voffB);
            PG8_BAR; PG8_WAIT_L(0); PG8_MMA(0, 1, At, B1); PG8_BAR;
            PG8_LDA(At, 0, 1); PG8_STAGE(PG8_SA(0, 0), a2, voffA);
            PG8_BAR; PG8_WAIT_L(0); PG8_MMA(1, 0, At, B0); PG8_BAR; PG8_SCHED;
            PG8_STAGE(PG8_SB(0, 1), b2 + hstepB, voffB);
            PG8_WAIT_V(6); PG8_BAR; PG8_MMA(1, 1, At, B1); PG8_BAR;
            PG8_LDB(B0, 1, 0); PG8_SCHED; PG8_LDA(At, 1, 0); PG8_STAGE(PG8_SA(0, 1), a2 + hstepA, voffA);
            PG8_WAIT_L(8); PG8_BAR; PG8_WAIT_L(0); PG8_MMA(0, 0, At, B0); PG8_BAR; PG8_SCHED;
            PG8_LDB(B1, 1, 1); PG8_STAGE(PG8_SB(1, 0), b3, voffB);
            PG8_BAR; PG8_WAIT_L(0); PG8_MMA(0, 1, At, B1); PG8_BAR;
            PG8_LDA(At, 1, 1); PG8_STAGE(PG8_SA(1, 0), a3, voffA);
            PG8_BAR; PG8_WAIT_L(0); PG8_MMA(1, 0, At, B0); PG8_BAR; PG8_SCHED;
            PG8_STAGE(PG8_SB(1, 1), b3 + hstepB, voffB);
            PG8_WAIT_V(6); PG8_BAR; PG8_MMA(1, 1, At, B1); PG8_BAR;
            }
        }
        if constexpr (ALIGN_EPI) { if (wr == 0) PG8_BAR; }
        if constexpr (!Epi::AFTER_DRAIN) { E(acc, cur, wr, wc, fr, fq); S.done(cur); }
        if (!has_next) break;
#pragma unroll
        for (int a = 0; a < 2; ++a)
#pragma unroll
            for (int b = 0; b < 2; ++b)
#pragma unroll
                for (int m = 0; m < 4; ++m)
#pragma unroll
                    for (int n = 0; n < 2; ++n) acc[a][b][m][n] = (f32x4){0.f, 0.f, 0.f, 0.f};
        cur = nxt; cA = nA; cB = nB; ++ui;
        if constexpr (ALIGN_EPI) { if (wr == 1) PG8_BAR; }
    }
    PG8_WAIT_V(0);
    if constexpr (!ALIGN_EPI) { if (wr == 0) PG8_BAR; }
    PG8_BAR;
    if constexpr (Epi::AFTER_DRAIN) { E.fused(acc, cur, wr, wc, fr, fq, lds, wid, lane); S.done(cur); }
#undef PG8_SA
#undef PG8_SB
#undef PG8_STAGE
#undef PG8_LDA
#undef PG8_LDB
#undef PG8_MMA
#undef PG8_WAIT_V
#undef PG8_WAIT_L
#undef PG8_BAR
#undef PG8_SCHED
}
}

using pg8::f32x4; using pg8::u32x4; using pg8::Unit; using pg8::cvt_pk_bf16;
typedef unsigned short bf16;
typedef float f32x2 __attribute__((ext_vector_type(2)));
typedef unsigned u32x2 __attribute__((ext_vector_type(2)));
#define LAS __attribute__((address_space(3)))
constexpr int NWAVES = 8, NTHR = 512;
constexpr int D = 2048, TP = 8192, TS = 128, TT = 8320, MP = 8448, NPAN = 33;
constexpr int DFF = 5376, DIN = 5120, DRNN = 2560, DA = 1024;
constexpr int NMODW = 18432, MODLD = 73728;
constexpr float EPS = 1e-6f;
constexpr int LDS_BYTES = 147456;
constexpr int MISC_OFF = 131072 + 320;

constexpr size_t al256(size_t x) { return (x + 255) & ~(size_t)255; }
constexpr size_t WS_CTL = 0, CTL_BYTES = 1u << 20;
constexpr size_t WS_WGU = WS_CTL + CTL_BYTES;
constexpr size_t WS_WD = WS_WGU + (size_t)8 * 10752 * 2048 * 2;
constexpr size_t WS_WINAB = WS_WD + (size_t)8 * 2048 * 5376 * 2;
constexpr size_t WS_WGLU = WS_WINAB + (size_t)2 * 5120 * 2048 * 2;
constexpr size_t WS_WOUTAB = WS_WGLU + (size_t)2 * 1024 * 1024 * 2;
constexpr size_t WS_WINC = WS_WOUTAB + (size_t)2 * 2048 * 2048 * 2;
constexpr size_t WS_WOUTC = WS_WINC + (size_t)2 * 5120 * 2048 * 2;
constexpr size_t WS_WGATE = WS_WOUTC + (size_t)2 * 2048 * 2560 * 2;
constexpr size_t WS_WADA = WS_WGATE + (size_t)2 * 5120 * 2560 * 2;
constexpr size_t WS_SC = WS_WADA + (size_t)73728 * 2048 * 2;
constexpr size_t WS_MOD = WS_SC + (size_t)256 * 2048 * 2;
constexpr size_t WS_X = WS_MOD + (size_t)256 * 73728 * 4;
constexpr size_t WS_H = WS_X + (size_t)MP * D * 4;
constexpr size_t WS_HID = WS_H + (size_t)MP * D * 2;
constexpr size_t WS_Z = WS_HID + (size_t)MP * DFF * 2;
constexpr size_t WS_XR = WS_Z + (size_t)MP * DIN * 2;
constexpr size_t WS_XC = WS_XR + (size_t)MP * DRNN * 4;
constexpr size_t WS_XCB = WS_XC + (size_t)MP * DRNN * 4;
constexpr size_t WS_AA = WS_XCB + (size_t)MP * DRNN * 2;
constexpr size_t WS_BB = WS_AA + (size_t)MP * DRNN * 4;
constexpr size_t WS_MIX = WS_BB + (size_t)MP * DRNN * 4;
constexpr size_t WS_YA = WS_MIX + (size_t)MP * DRNN * 2;
constexpr size_t WS_OB = WS_YA + (size_t)MP * DA * 2;
constexpr size_t WS_S5E = WS_OB + (size_t)TP * 1024 * 4;
constexpr size_t WS_LRUP = WS_S5E + (size_t)4 * 64 * 8 * 128 * 4;
constexpr size_t WS_LB = WS_LRUP + (size_t)4 * 16 * 2560 * 2 * 4;
constexpr size_t WS_LL = WS_LB + 2 * 1024 * 4;
constexpr size_t WS_PART = WS_LL + 2 * 2560 * 4;
constexpr size_t WS_END = WS_PART + (size_t)21 * 128 * 2048 * 4;
constexpr size_t WS_HT = WS_XR, WS_HS = WS_XC, WS_QG = WS_AA, WS_HD = WS_BB;
constexpr int CW_BAR = 4096;

constexpr size_t O_Y = 0;
constexpr size_t O_PS5R = (size_t)TT * D;
constexpr size_t O_PS5I = O_PS5R + 2 * 4 * 64 * 64;
constexpr size_t O_PHG = O_PS5I + 2 * 4 * 64 * 64;
constexpr size_t O_PLRU = O_PHG + (size_t)2 * 4 * 8 * 128 * 128;
constexpr size_t O_PCONV = O_PLRU + 2 * 4 * 2560;
constexpr size_t O_SS5R = O_PCONV + 2 * 4 * 3 * 2560;
constexpr size_t O_SS5I = O_SS5R + (size_t)2 * 128 * 64 * 64;
constexpr size_t O_SHG = O_SS5I + (size_t)2 * 128 * 64 * 64;
constexpr size_t O_SLRU = O_SHG + (size_t)2 * 128 * 8 * 128 * 128;
constexpr size_t O_SCONV = O_SLRU + (size_t)2 * 128 * 2560;
constexpr size_t O_END = O_SCONV + (size_t)2 * 128 * 3 * 2560;

enum { I_XP = 0, I_XS, I_S5RE, I_S5IM, I_HG, I_LRU, I_CONV, I_CP, I_CS, I_NW, I_FNW, I_WADA, I_BADA, I_WGU, I_WD, I_WINAB, I_LAMRE, I_LAMIM, I_BRE, I_BIM, I_CRE, I_CIM, I_S5D, I_LSTEP,
       I_WGLU, I_BGLU, I_LBL, I_HGNW, I_WOUTAB, I_WINC, I_CONVW, I_CONVB, I_WGA, I_BGA, I_WGX, I_BGX, I_LAMBDA, I_WOUTC, N_IN };

__device__ __forceinline__ float bflo(unsigned w) { return __uint_as_float(w << 16); }
__device__ __forceinline__ float bfhi(unsigned w) { return __uint_as_float(w & 0xffff0000u); }
__device__ __forceinline__ float fsigmoid(float x) { return __builtin_amdgcn_rcpf(1.0f + __expf(-x)); }
__device__ __forceinline__ float fsilu(float x) { return x * fsigmoid(x); }
__device__ __forceinline__ float fgelu(float x) { const float u = 0.7978845608f * (x + 0.044715f * x * x * x); return x * fsigmoid(2.0f * u); }
__device__ __forceinline__ int mrow_of(int row) { return row < TP ? (row >> 11) : ((row - TP + 4) < 131 ? (row - TP + 4) : 131); }
#define DPP_F(p, ctrl) __int_as_float(__builtin_amdgcn_update_dpp(0, __float_as_int(p), (ctrl), 0xF, 0xF, true))
__device__ __forceinline__ float row16_sum(float p) { p += DPP_F(p, 0xB1); p += DPP_F(p, 0x4E); p += DPP_F(p, 0x141); p += DPP_F(p, 0x140); return p; }
__device__ __forceinline__ float wave_sum(float v) {
    v = row16_sum(v); const int b = __float_as_int(v);
    return (__int_as_float(__builtin_amdgcn_readlane(b, 0)) + __int_as_float(__builtin_amdgcn_readlane(b, 16))) + (__int_as_float(__builtin_amdgcn_readlane(b, 32)) + __int_as_float(__builtin_amdgcn_readlane(b, 48)));
}
__device__ __forceinline__ float swz_xor16(float v) { return __int_as_float(__builtin_amdgcn_ds_swizzle(__float_as_int(v), 0x401F)); }
__device__ __forceinline__ float oct_sum(float p) { p += DPP_F(p, 0xB1); p += DPP_F(p, 0x4E); p += DPP_F(p, 0x141); return p; }
__device__ __forceinline__ void sincos_acc(float x, float& s, float& c) {
    const float k = rintf(x * 0.636619772f);
    float y = fmaf(k, -1.5703125f, x); y = fmaf(k, -4.837512969970703125e-4f, y); y = fmaf(k, -7.54978995489188216e-8f, y);
    const float y2 = y * y;
    float sp = fmaf(y2, 2.7557319e-6f, -1.9841270e-4f); sp = fmaf(sp, y2, 8.3333333e-3f); sp = fmaf(sp, y2, -1.6666667e-1f); sp = fmaf(sp * y2, y, y);
    float cp = fmaf(y2, -2.7557319e-7f, 2.4801587e-5f); cp = fmaf(cp, y2, -1.3888889e-3f); cp = fmaf(cp, y2, 4.1666667e-2f); cp = fmaf(cp, y2, -0.5f); cp = fmaf(cp, y2, 1.0f);
    const int q = ((int)k) & 3;
    s = (q == 0) ? sp : (q == 1) ? cp : (q == 2) ? -sp : -cp;
    c = (q == 0) ? cp : (q == 1) ? -sp : (q == 2) ? -cp : sp;
}

#define XB_TMO      128
#define XB_XCNT(j)  (256  + 64 * (j))
#define XB_XSUB(j)  (1280 + 64 * (j))
#define XB_XGEN(j)  (2304 + 64 * (j))
#define XB_TOP      3328
#define XB_TOPGEN   3392
#define XCD_BAR_WORDS 3456
#define XB_SPIN_CAP (1u << 18)
__device__ __forceinline__ unsigned xb_ld(unsigned* p)              { return __hip_atomic_load(p, __ATOMIC_RELAXED, __HIP_MEMORY_SCOPE_AGENT); }
__device__ __forceinline__ unsigned xb_add(unsigned* p, unsigned v) { return __hip_atomic_fetch_add(p, v, __ATOMIC_RELAXED, __HIP_MEMORY_SCOPE_AGENT); }
__device__ __forceinline__ unsigned xb_xcc_id() { return (unsigned)__builtin_amdgcn_s_getreg((3 << 11) | 20) & 0xFu; }
#define XB_SPIN(cond, bar) do { unsigned _sp = 0; while (cond) { __builtin_amdgcn_s_sleep(1); \
    if ((++_sp & 255u) == 0u) { if (xb_ld(&(bar)[XB_TMO])) break; if (_sp > XB_SPIN_CAP) { atomicAdd(&(bar)[XB_TMO], 1u); break; } } } } while (0)
struct XcdBarrier { unsigned* bar; unsigned x; volatile LAS unsigned* st; int wid; };
__device__ __forceinline__ bool xb_leader(int wid) { return wid == 0 && __builtin_amdgcn_mbcnt_hi(~0u, __builtin_amdgcn_mbcnt_lo(~0u, 0u)) == 0u; }
__device__ __forceinline__ XcdBarrier xcd_barrier_post(unsigned* bar, volatile LAS unsigned* st, int wid) {
    XcdBarrier b; b.bar = bar; b.x = xb_xcc_id(); b.st = st; b.wid = wid;
    if (xb_leader(wid)) (void)xb_add(&bar[XB_XCNT(b.x)], 1u);
    return b;
}
__device__ __forceinline__ void xcd_barrier_complete(unsigned* bar, unsigned x, unsigned& nloc, unsigned& nx) {
    const unsigned G = gridDim.x * gridDim.y * gridDim.z;
    unsigned sum, cnt, mine, sp = 0u;
    for (;;) {
        sum = 0u; cnt = 0u; mine = 0u;
#pragma unroll
        for (unsigned j = 0; j < 16; ++j) { const unsigned c = xb_ld(&bar[XB_XCNT(j)]); sum += c; cnt += (c > 0u) ? 1u : 0u; mine = (j == x) ? c : mine; }
        if (sum == G) break;
        __builtin_amdgcn_s_sleep(1);
        if ((++sp & 255u) == 0u) { if (xb_ld(&bar[XB_TMO])) break; if (sp > XB_SPIN_CAP) { atomicAdd(&bar[XB_TMO], 1u); break; } }
    }
    nloc = mine > 0u ? mine : 1u; nx = cnt > 0u ? cnt : 1u;
}
__device__ __forceinline__ void xcd_barrier(const XcdBarrier& b) {
    asm volatile("s_waitcnt vmcnt(0)" ::: "memory");
    __syncthreads();
    if (xb_leader(b.wid)) {
        unsigned* bar = b.bar;
        __builtin_amdgcn_s_waitcnt(0);
        unsigned nloc = b.st[0], nx = b.st[1];
        if (nloc == 0u) { xcd_barrier_complete(bar, b.x, nloc, nx); b.st[0] = nloc; b.st[1] = nx; }
        const unsigned old = xb_add(&bar[XB_XSUB(b.x)], 1u);
        const unsigned gen = old / nloc;
        if (old + 1u == (gen + 1u) * nloc) {
            __builtin_amdgcn_fence(__ATOMIC_RELEASE, "agent");
            asm volatile("s_waitcnt vmcnt(0)" ::: "memory");
            const unsigned og = xb_add(&bar[XB_TOP], 1u);
            const unsigned tg = og / nx;
            if (og + 1u == (tg + 1u) * nx) xb_add(&bar[XB_TOPGEN], 1u);
            else XB_SPIN(xb_ld(&bar[XB_TOPGEN]) == tg, bar);
            __builtin_amdgcn_fence(__ATOMIC_ACQUIRE, "agent");
            xb_add(&bar[XB_XGEN(b.x)], 1u);
            asm volatile("s_waitcnt vmcnt(0)" ::: "memory");
        } else {
            XB_SPIN(xb_ld(&bar[XB_XGEN(b.x)]) == gen, bar);
            __builtin_amdgcn_fence(__ATOMIC_ACQUIRE, "agent");
            asm volatile("s_waitcnt vmcnt(0)" ::: "memory");
        }
    }
    __syncthreads();
}

struct EpiF32B {
    static constexpr bool PERM = false, AFTER_DRAIN = false;
    float* C; int ldc; const float* bias;
    __device__ __forceinline__ void operator()(const f32x4 (&acc)[2][2][4][2], const Unit& u, int wr, int wc, int fr, int fq) const {
        const int row0 = u.pm * 256 + wr * 64 + fr, col0 = u.pn * 256 + wc * 32 + 4 * fq;
        f32x4 bv[2][2];
#pragma unroll
        for (int bj = 0; bj < 2; ++bj)
#pragma unroll
            for (int n = 0; n < 2; ++n) bv[bj][n] = *(const f32x4*)(bias + col0 + bj * 128 + n * 16);
#pragma unroll
        for (int ai = 0; ai < 2; ++ai)
#pragma unroll
            for (int m = 0; m < 4; ++m) { float* rowp = C + (size_t)(row0 + ai * 128 + m * 16) * ldc + col0;
#pragma unroll
                for (int bj = 0; bj < 2; ++bj)
#pragma unroll
                    for (int n = 0; n < 2; ++n) *(f32x4*)(rowp + bj * 128 + n * 16) = acc[ai][bj][m][n] + bv[bj][n]; }
    }
};
struct EpiBf16 {
    static constexpr bool PERM = true, AFTER_DRAIN = false;
    bf16* O; int ldc;
    __device__ __forceinline__ void operator()(const f32x4 (&acc)[2][2][4][2], const Unit& u, int wr, int wc, int fr, int fq) const {
        const int row0 = u.pm * 256 + wr * 64 + fr, col0 = u.pn * 256 + wc * 32 + 8 * fq;
#pragma unroll
        for (int ai = 0; ai < 2; ++ai)
#pragma unroll
            for (int m = 0; m < 4; ++m) { bf16* rowp = O + (size_t)(row0 + ai * 128 + m * 16) * ldc + col0;
#pragma unroll
                for (int bj = 0; bj < 2; ++bj) { const f32x4 v0 = acc[ai][bj][m][0], v1 = acc[ai][bj][m][1];
                    u32x4 w; w.x = cvt_pk_bf16(v0[0], v0[1]); w.y = cvt_pk_bf16(v0[2], v0[3]); w.z = cvt_pk_bf16(v1[0], v1[1]); w.w = cvt_pk_bf16(v1[2], v1[3]);
                    *(u32x4*)(rowp + bj * 128) = w; } }
    }
};
struct EpiGU {
    static constexpr bool PERM = true, AFTER_DRAIN = false;
    bf16* O;
    __device__ __forceinline__ void operator()(const f32x4 (&acc)[2][2][4][2], const Unit& u, int wr, int wc, int fr, int fq) const {
        const int row0 = u.pm * 256 + wr * 64 + fr, col0 = u.pn * 128 + wc * 32 + 8 * fq;
#pragma unroll
        for (int ai = 0; ai < 2; ++ai)
#pragma unroll
            for (int m = 0; m < 4; ++m) { bf16* rowp = O + (size_t)(row0 + ai * 128 + m * 16) * DFF + col0;
                float h[8];
#pragma unroll
                for (int n = 0; n < 2; ++n)
#pragma unroll
                    for (int i = 0; i < 4; ++i) h[4 * n + i] = fsilu(acc[ai][0][m][n][i]) * acc[ai][1][m][n][i];
                u32x4 w; w.x = cvt_pk_bf16(h[0], h[1]); w.y = cvt_pk_bf16(h[2], h[3]); w.z = cvt_pk_bf16(h[4], h[5]); w.w = cvt_pk_bf16(h[6], h[7]);
                *(u32x4*)rowp = w; }
    }
};
struct EpiRes {
    static constexpr bool PERM = false, AFTER_DRAIN = false;
    float* X; const float* mod; float scale;
    __device__ __forceinline__ void operator()(const f32x4 (&acc)[2][2][4][2], const Unit& u, int wr, int wc, int fr, int fq) const {
        const int row0 = u.pm * 256 + wr * 64 + fr, col0 = u.pn * 256 + wc * 32 + 4 * fq;
        float* xb = X + (size_t)row0 * D + col0; const float* mp = mod + (size_t)(row0 >> 11) * MODLD + col0;
        f32x4 g[2][2];
#pragma unroll
        for (int bj = 0; bj < 2; ++bj)
#pragma unroll
            for (int n = 0; n < 2; ++n) g[bj][n] = *(const f32x4*)(mp + bj * 128 + n * 16) * scale;
#pragma unroll
        for (int ai = 0; ai < 2; ++ai) { f32x4 xv[4][2][2];
#pragma unroll
            for (int m = 0; m < 4; ++m)
#pragma unroll
                for (int bj = 0; bj < 2; ++bj)
#pragma unroll
                    for (int n = 0; n < 2; ++n) xv[m][bj][n] = *(const f32x4*)(xb + (size_t)(ai * 128 + m * 16) * D + bj * 128 + n * 16);
#pragma unroll
            for (int m = 0; m < 4; ++m)
#pragma unroll
                for (int bj = 0; bj < 2; ++bj)
#pragma unroll
                    for (int n = 0; n < 2; ++n) *(f32x4*)(xb + (size_t)(ai * 128 + m * 16) * D + bj * 128 + n * 16) = xv[m][bj][n] + g[bj][n] * acc[ai][bj][m][n];
            asm volatile("" ::: "memory"); }
    }
};
struct EpiResPart {
    static constexpr bool PERM = false, AFTER_DRAIN = false;
    float* P; const float* mod; float scale;
    __device__ __forceinline__ void operator()(const f32x4 (&acc)[2][2][4][2], const Unit& u, int wr, int wc, int fr, int fq) const {
        const int row0 = u.pm * 256 + wr * 64 + fr, col0 = u.pn * 256 + wc * 32 + 4 * fq;
#pragma unroll
        for (int m = 0; m < 4; ++m) { const int row = row0 + m * 16;
            if (row < TT) { float* pp = P + ((size_t)u.ks * 128 + (row - TP)) * D + col0; const float* mp = mod + (size_t)mrow_of(row) * MODLD + col0;
#pragma unroll
                for (int bj = 0; bj < 2; ++bj)
#pragma unroll
                    for (int n = 0; n < 2; ++n) { const f32x4 g = *(const f32x4*)(mp + bj * 128 + n * 16); *(f32x4*)(pp + bj * 128 + n * 16) = (g * scale) * acc[0][bj][m][n]; } }
            asm volatile("" ::: "memory"); }
    }
};
struct EpiInC {
    static constexpr bool PERM = true, AFTER_DRAIN = false;
    bf16* GB; bf16* XR;
    __device__ __forceinline__ void operator()(const f32x4 (&acc)[2][2][4][2], const Unit& u, int wr, int wc, int fr, int fq) const {
        const int row0 = u.pm * 256 + wr * 64 + fr; const bool gate = u.pn < 10; bf16* base = gate ? GB : XR; const int col0 = (gate ? u.pn : u.pn - 10) * 256 + wc * 32 + 8 * fq;
#pragma unroll
        for (int ai = 0; ai < 2; ++ai)
#pragma unroll
            for (int m = 0; m < 4; ++m) { bf16* rowp = base + (size_t)(row0 + ai * 128 + m * 16) * DRNN + col0;
#pragma unroll
                for (int bj = 0; bj < 2; ++bj) { f32x4 v0 = acc[ai][bj][m][0], v1 = acc[ai][bj][m][1];
                    if (gate) {
#pragma unroll
                        for (int i = 0; i < 4; ++i) { v0[i] = fgelu(v0[i]); v1[i] = fgelu(v1[i]); } }
                    u32x4 w; w.x = cvt_pk_bf16(v0[0], v0[1]); w.y = cvt_pk_bf16(v0[2], v0[3]); w.z = cvt_pk_bf16(v1[0], v1[1]); w.w = cvt_pk_bf16(v1[2], v1[3]);
                    *(u32x4*)(rowp + bj * 128) = w; } }
    }
};
struct EpiGlu {
    static constexpr bool PERM = true, AFTER_DRAIN = false;
    bf16* O; const bf16* YA; const float* bias;
    __device__ __forceinline__ void operator()(const f32x4 (&acc)[2][2][4][2], const Unit& u, int wr, int wc, int fr, int fq) const {
        const int row0 = u.pm * 256 + wr * 64 + fr, col0 = u.pn * 256 + wc * 32 + 8 * fq;
        f32x4 bv[2][2];
#pragma unroll
        for (int bj = 0; bj < 2; ++bj)
#pragma unroll
            for (int n = 0; n < 2; ++n) bv[bj][n] = *(const f32x4*)(bias + col0 + bj * 128 + 4 * n);
#pragma unroll
        for (int ai = 0; ai < 2; ++ai)
#pragma unroll
            for (int m = 0; m < 4; ++m) { const size_t row = (size_t)(row0 + ai * 128 + m * 16);
#pragma unroll
                for (int bj = 0; bj < 2; ++bj) { const u32x4 yv = *(const u32x4*)(YA + row * DA + col0 + bj * 128);
                    const f32x4 v0 = acc[ai][bj][m][0] + bv[bj][0], v1 = acc[ai][bj][m][1] + bv[bj][1];
                    u32x4 w; w.x = cvt_pk_bf16(bflo(yv.x) * fsigmoid(v0[0]), bfhi(yv.x) * fsigmoid(v0[1])); w.y = cvt_pk_bf16(bflo(yv.y) * fsigmoid(v0[2]), bfhi(yv.y) * fsigmoid(v0[3]));
                    w.z = cvt_pk_bf16(bflo(yv.z) * fsigmoid(v1[0]), bfhi(yv.z) * fsigmoid(v1[1])); w.w = cvt_pk_bf16(bflo(yv.w) * fsigmoid(v1[2]), bfhi(yv.w) * fsigmoid(v1[3]));
                    *(u32x4*)(O + row * D + col0 + bj * 128) = w; }
                asm volatile("" ::: "memory"); }
    }
};
__device__ __forceinline__ float em1_neg(float x) { float p = fmaf(x, 1.0f / 720.0f, 1.0f / 120.0f); p = fmaf(p, x, 1.0f / 24.0f); p = fmaf(p, x, 1.0f / 6.0f); p = fmaf(p, x, 0.5f); p = fmaf(p, x, 1.0f); p *= x;
    return x > -0.25f ? p : __expf(x) - 1.0f; }
struct EpiGate {
    static constexpr bool PERM = false, AFTER_DRAIN = false;
    unsigned* AB; const bf16* XC; const float* bga; const float* bgx; const float* ll;
    __device__ __forceinline__ void operator()(const f32x4 (&acc)[2][2][4][2], const Unit& u, int wr, int wc, int fr, int fq) const {
        const int row0 = u.pm * 256 + wr * 64 + fr, ch0 = u.pn * 128 + wc * 32 + 4 * fq;
#pragma unroll
        for (int n = 0; n < 2; ++n) { const f32x4 ba = *(const f32x4*)(bga + ch0 + 16 * n), bx = *(const f32x4*)(bgx + ch0 + 16 * n), lv = *(const f32x4*)(ll + ch0 + 16 * n);
#pragma unroll
            for (int ai = 0; ai < 2; ++ai)
#pragma unroll
                for (int m = 0; m < 4; ++m) { const int row = row0 + ai * 128 + m * 16;
                    if (row < TT) { const size_t off = (size_t)row * DRNN + ch0 + 16 * n; const u32x2 xw = *(const u32x2*)(XC + off); const f32x4 xc = (f32x4){bflo(xw.x), bfhi(xw.x), bflo(xw.y), bfhi(xw.y)}; u32x4 o;
#pragma unroll
                        for (int i = 0; i < 4; ++i) { const float r = fsigmoid(acc[ai][0][m][n][i] + ba[i]), ig = fsigmoid(acc[ai][1][m][n][i] + bx[i]);
                            const float la = r * lv[i]; o[i] = cvt_pk_bf16(la, sqrtf(fmaxf(-em1_neg(2.0f * la), 0.0f)) * ig * xc[i]); }
                        *(u32x4*)(AB + off) = o; }
                    asm volatile("" ::: "memory"); } }
    }
};


struct Args { const float* in[N_IN]; float* out; unsigned char* ws; int lo, hi; };
typedef const __attribute__((address_space(4))) unsigned long long* kargp_t;
__device__ __forceinline__ kargp_t kargs() { kargp_t p = (kargp_t)__builtin_amdgcn_kernarg_segment_ptr(); asm volatile("" : "+s"(p)); return p; }
#define INP(i) ((const float*)kargs()[(i)])
#define OUTP ((float*)kargs()[N_IN])
#define WSP ((unsigned char*)kargs()[N_IN + 1])
struct Frame { LAS unsigned char* lds; int tid, lane, wave, vcu, G, gw, NGW, gt, NT, bx; };

__device__ __forceinline__ void tr_item(const float* W, int ldw, int k0, int n0, bf16* WT, int ldk, int drow0, int lane) {
    const int n4 = (lane & 15) * 4, kg = lane >> 4; f32x4 v[2][8];
#pragma unroll
    for (int kh = 0; kh < 2; ++kh) { const float* src = W + (size_t)(k0 + kh * 32 + kg * 8) * ldw + n0 + n4;
#pragma unroll
        for (int i = 0; i < 8; ++i) v[kh][i] = __builtin_nontemporal_load((const f32x4*)(src + (size_t)i * ldw)); }
#pragma unroll
    for (int kh = 0; kh < 2; ++kh)
#pragma unroll
        for (int e = 0; e < 4; ++e) { u32x4 o; o.x = cvt_pk_bf16(v[kh][0][e], v[kh][1][e]); o.y = cvt_pk_bf16(v[kh][2][e], v[kh][3][e]); o.z = cvt_pk_bf16(v[kh][4][e], v[kh][5][e]); o.w = cvt_pk_bf16(v[kh][6][e], v[kh][7][e]);
            *(u32x4*)(WT + (size_t)(drow0 + n4 + e) * ldk + k0 + kh * 32 + kg * 8) = o; }
}
constexpr int IT_GU = 32 * 168, IT_D = 84 * 32, IT_INAB = 32 * 80, IT_GLU = 16 * 16, IT_OUTAB = 32 * 32, IT_INC = 32 * 80, IT_OUTC = 40 * 32;
constexpr int NITEMS_CONV = 8 * IT_GU + 8 * IT_D + 2 * IT_INAB + 2 * IT_GLU + 2 * IT_OUTAB + 2 * IT_INC + 2 * IT_OUTC;

__device__ __forceinline__ void conv_item(int it, int lane) {
    unsigned char* ws = WSP; int r = it;
    if (r < 8 * IT_GU) { const int idx = r / IT_GU; r -= idx * IT_GU; const int kb = r / 168, nb = r % 168, n0 = 64 * nb;
        const int drow = n0 < DFF ? (n0 >> 7) * 256 + (n0 & 127) : ((n0 - DFF) >> 7) * 256 + 128 + ((n0 - DFF) & 127);
        tr_item(INP(I_WGU) + (size_t)idx * 2048 * 10752, 10752, 64 * kb, n0, (bf16*)(ws + WS_WGU) + (size_t)idx * 10752 * 2048, 2048, drow, lane); return; }
    r -= 8 * IT_GU;
    if (r < 8 * IT_D) { const int idx = r / IT_D; r -= idx * IT_D; const int kb = r / 32, nb = r % 32;
        tr_item(INP(I_WD) + (size_t)idx * 5376 * 2048, 2048, 64 * kb, 64 * nb, (bf16*)(ws + WS_WD) + (size_t)idx * 2048 * 5376, 5376, 64 * nb, lane); return; }
    r -= 8 * IT_D;
    if (r < 2 * IT_INAB) { const int idx = r / IT_INAB; r -= idx * IT_INAB; const int kb = r / 80, nb = r % 80;
        tr_item(INP(I_WINAB) + (size_t)idx * 2048 * 5120, 5120, 64 * kb, 64 * nb, (bf16*)(ws + WS_WINAB) + (size_t)idx * 5120 * 2048, 2048, 64 * nb, lane); return; }
    r -= 2 * IT_INAB;
    if (r < 2 * IT_GLU) { const int idx = r / IT_GLU; r -= idx * IT_GLU; const int kb = r / 16, nb = r % 16;
        tr_item(INP(I_WGLU) + (size_t)idx * 1024 * 1024, 1024, 64 * kb, 64 * nb, (bf16*)(ws + WS_WGLU) + (size_t)idx * 1024 * 1024, 1024, 64 * nb, lane); return; }
    r -= 2 * IT_GLU;
    if (r < 2 * IT_OUTAB) { const int idx = r / IT_OUTAB; r -= idx * IT_OUTAB; const int kb = r / 32, nb = r % 32;
        tr_item(INP(I_WOUTAB) + (size_t)idx * 2048 * 2048, 2048, 64 * kb, 64 * nb, (bf16*)(ws + WS_WOUTAB) + (size_t)idx * 2048 * 2048, 2048, 64 * nb, lane); return; }
    r -= 2 * IT_OUTAB;
    if (r < 2 * IT_INC) { const int idx = r / IT_INC; r -= idx * IT_INC; const int kb = r / 80, nb = r % 80;
        tr_item(INP(I_WINC) + (size_t)idx * 2048 * 5120, 5120, 64 * kb, 64 * nb, (bf16*)(ws + WS_WINC) + (size_t)idx * 5120 * 2048, 2048, 64 * nb, lane); return; }
    r -= 2 * IT_INC;
    { const int idx = r / IT_OUTC; r -= idx * IT_OUTC; const int kb = r / 32, nb = r % 32;
      tr_item(INP(I_WOUTC) + (size_t)idx * 2560 * 2048, 2048, 64 * kb, 64 * nb, (bf16*)(ws + WS_WOUTC) + (size_t)idx * 2048 * 2560, 2560, 64 * nb, lane); }
}

constexpr int IT_LAYER = 2 * IT_GU + 2 * IT_D + IT_INAB + IT_GLU + IT_OUTAB;
static_assert(IT_LAYER == 2 * IT_GU + 2 * IT_D + IT_INC + IT_OUTC && 4 * IT_LAYER == NITEMS_CONV, "per-layer conversion item counts");
__device__ __forceinline__ void conv_ordered(int oi, int lane) {
    const int l = oi / IT_LAYER, j = l >> 1; int r = oi - l * IT_LAYER; int kind_base;
    const int B_D = 8 * IT_GU, B_INAB = B_D + 8 * IT_D, B_GLU = B_INAB + 2 * IT_INAB, B_OUTAB = B_GLU + 2 * IT_GLU, B_INC = B_OUTAB + 2 * IT_OUTAB, B_OUTC = B_INC + 2 * IT_INC;
    if (r < IT_GU) kind_base = (2 * l) * IT_GU;
    else if ((r -= IT_GU) < IT_D) kind_base = B_D + (2 * l) * IT_D;
    else { r -= IT_D;
        if ((l & 1) == 0) {
            if (r < IT_INAB) kind_base = B_INAB + j * IT_INAB;
            else if ((r -= IT_INAB) < IT_GLU) kind_base = B_GLU + j * IT_GLU;
            else if ((r -= IT_GLU) < IT_OUTAB) kind_base = B_OUTAB + j * IT_OUTAB;
            else { r -= IT_OUTAB; if (r < IT_GU) kind_base = (2 * l + 1) * IT_GU; else { r -= IT_GU; kind_base = B_D + (2 * l + 1) * IT_D; } }
        } else {
            if (r < IT_INC) kind_base = B_INC + j * IT_INC;
            else if ((r -= IT_INC) < IT_OUTC) kind_base = B_OUTC + j * IT_OUTC;
            else { r -= IT_OUTC; if (r < IT_GU) kind_base = (2 * l + 1) * IT_GU; else { r -= IT_GU; kind_base = B_D + (2 * l + 1) * IT_D; } }
        }
    }
    conv_item(kind_base + r, lane);
}
constexpr int CONV_IPW = 5;
constexpr int SLOT_GU = (256 - 106) * 8 * CONV_IPW, SLOT_IN = (256 - 148) * 8 * CONV_IPW;
constexpr int SLOT_LAYER = 2 * SLOT_GU + SLOT_IN;
constexpr int CONV_PRO = 4 * IT_LAYER - 3 * SLOT_LAYER > IT_LAYER ? 4 * IT_LAYER - 3 * SLOT_LAYER : IT_LAYER;
static_assert(CONV_PRO >= IT_LAYER && CONV_PRO + SLOT_LAYER >= 2 * IT_LAYER && CONV_PRO + 2 * SLOT_LAYER >= 3 * IT_LAYER && CONV_PRO + 3 * SLOT_LAYER >= 4 * IT_LAYER, "every layer's weights are converted before the layer starts");
__device__ __forceinline__ void conv_slot(const Frame& F, int l, int slot, int first_idle) {
    if (l >= 3 || F.bx < first_idle) return;
    const int start = CONV_PRO + l * SLOT_LAYER + (slot == 0 ? 0 : slot == 1 ? SLOT_GU : SLOT_GU + SLOT_IN), n = (slot == 1 ? SLOT_IN : SLOT_GU), nw = (256 - first_idle) * 8, w = (F.bx - first_idle) * 8 + F.wave;
    for (int q = 0; q < CONV_IPW; ++q) { const int it = start + q * nw + w; if (q * nw + w < n && it < NITEMS_CONV) conv_ordered(it, F.lane); }
}

__device__ __forceinline__ void phase_ada(const Frame& F, int item0, int istride) {
    unsigned char* ws = WSP; const bf16* SC = (const bf16*)(ws + WS_SC); float* MOD = (float*)(ws + WS_MOD);
    const int r = F.lane & 15, kq = F.lane >> 4;
    for (int item = item0; item < 1152; item += istride) { const int l = item / 288, n0 = (item % 288) * 64;
        const float* W = INP(I_WADA) + (size_t)l * 2048 * NMODW + (size_t)(kq * 8) * NMODW + n0 + 4 * r; const bf16* sp = SC + (size_t)r * D + kq * 8;
        f32x4 acc[9][4];
#pragma unroll
        for (int bt = 0; bt < 9; ++bt)
#pragma unroll
            for (int e = 0; e < 4; ++e) acc[bt][e] = (f32x4){0.f, 0.f, 0.f, 0.f};
#pragma unroll 2
        for (int ks = 0; ks < 64; ++ks) { f32x4 w[8];
#pragma unroll
            for (int i = 0; i < 8; ++i) w[i] = __builtin_nontemporal_load((const f32x4*)(W + (size_t)(ks * 32 + i) * NMODW));
            pg8::bf16x8 wb[4];
#pragma unroll
            for (int e = 0; e < 4; ++e) { u32x4 o; o.x = cvt_pk_bf16(w[0][e], w[1][e]); o.y = cvt_pk_bf16(w[2][e], w[3][e]); o.z = cvt_pk_bf16(w[4][e], w[5][e]); o.w = cvt_pk_bf16(w[6][e], w[7][e]); wb[e] = __builtin_bit_cast(pg8::bf16x8, o); }
#pragma unroll
            for (int bt = 0; bt < 9; ++bt) { const pg8::bf16x8 sa = *(const pg8::bf16x8*)(sp + (size_t)(bt * 16) * D + ks * 32);
#pragma unroll
                for (int e = 0; e < 4; ++e) acc[bt][e] = __builtin_amdgcn_mfma_f32_16x16x32_bf16(wb[e], sa, acc[bt][e], 0, 0, 0); }
        }
        const float* bias = INP(I_BADA) + (size_t)l * NMODW + n0 + 16 * kq; f32x4 bv[4];
#pragma unroll
        for (int t = 0; t < 4; ++t) bv[t] = *(const f32x4*)(bias + 4 * t);
#pragma unroll
        for (int bt = 0; bt < 9; ++bt) { const int brow = bt * 16 + r;
            if (brow < 132) { float* op = MOD + (size_t)brow * MODLD + (size_t)l * NMODW + n0 + 16 * kq;
#pragma unroll
                for (int t = 0; t < 4; ++t) *(f32x4*)(op + 4 * t) = (f32x4){acc[bt][0][t], acc[bt][1][t], acc[bt][2][t], acc[bt][3][t]} + bv[t]; } }
    }
}

__device__ __forceinline__ void phase_prologue(const Frame& F) {
    unsigned char* ws = WSP;
    { f32x4* X4 = (f32x4*)(ws + WS_X); const f32x4* xp = (const f32x4*)INP(I_XP); const f32x4* xs = (const f32x4*)INP(I_XS);
      for (int i = F.gt; i < MP * 512; i += F.NT) { const int row = i >> 9; f32x4 v = (f32x4){0.f, 0.f, 0.f, 0.f};
          if (row < TP) v = xp[i]; else if (row < TT) v = xs[i - TP * 512]; X4[i] = v; } }
    { u32x4* Hp = (u32x4*)(ws + WS_H + (size_t)TT * D * 2); for (int i = F.gt; i < (MP - TT) * D / 8; i += F.NT) Hp[i] = (u32x4){0u, 0u, 0u, 0u}; }
    { u32x2* S2 = (u32x2*)(ws + WS_SC);
      for (int i = F.gt; i < 256 * 512; i += F.NT) { const int row = i >> 9, c4 = i & 511; f32x4 v = (f32x4){0.f, 0.f, 0.f, 0.f};
          if (row < 4) v = ((const f32x4*)INP(I_CP))[row * 512 + c4]; else if (row < 132) v = ((const f32x4*)INP(I_CS))[(row - 4) * 512 + c4];
          u32x2 w; w.x = cvt_pk_bf16(fsilu(v[0]), fsilu(v[1])); w.y = cvt_pk_bf16(fsilu(v[2]), fsilu(v[3])); S2[i] = w; } }
    { float* LB = (float*)(ws + WS_LB); const float* lg = INP(I_LBL);
      for (int i = F.gt; i < 1024; i += F.NT) { const float l0 = lg[i], l1 = lg[1024 + i], mx = fmaxf(l0, l1), e0 = expf(l0 - mx), e1 = expf(l1 - mx), s0 = e0 / (e0 + e1), s1 = e1 / (e0 + e1);
          LB[i] = s0 - s0; LB[1024 + i] = (s0 + s1) - s0; } }
    { float* LL = (float*)(ws + WS_LL); const float* lam = INP(I_LAMBDA);
      for (int i = F.gt; i < 2 * DRNN; i += F.NT) LL[i] = -8.0f * log1pf(expf(-lam[i])); }
    { bf16* WG = (bf16*)(ws + WS_WGATE);
      for (int i = F.gt; i < 2 * 20 * 256 * 48; i += F.NT) { const int k8 = i % 48, r = (i / 48) & 255, pn = (i / (48 * 256)) % 20, j = i / (48 * 256 * 20);
          const int ch = 128 * pn + (r & 127), bl = ch / 160, jc = ch % 160; int ks = ((pn * 128) / 160) * 160; ks = ks < 2176 ? ks : 2176;
          const float* W = (r < 128 ? INP(I_WGA) : INP(I_WGX)) + (size_t)(j * 16 + bl) * 160 * 160 + jc; float v[8];
#pragma unroll
          for (int e = 0; e < 8; ++e) { const int ci = ks + k8 * 8 + e; const int cin = ci - bl * 160; v[e] = (cin >= 0 && cin < 160) ? W[(size_t)cin * 160] : 0.f; }
          u32x4 w; w.x = cvt_pk_bf16(v[0], v[1]); w.y = cvt_pk_bf16(v[2], v[3]); w.z = cvt_pk_bf16(v[4], v[5]); w.w = cvt_pk_bf16(v[6], v[7]);
          *(u32x4*)(WG + ((size_t)(j * 20 + pn) * 256 + r) * 2560 + ks + k8 * 8) = w; } }
}


__device__ __forceinline__ void phase_ada_conv(const Frame& F) {
    const int pair = F.bx >> 1, odd = F.bx & 1, nA = odd ? 4 : 5;
    if (F.G == 256) {
        if (F.wave < nA) phase_ada(F, pair * 9 + (odd ? 5 + F.wave : F.wave), 1152);
        else { const int cw = pair * 7 + (odd ? 3 + (F.wave - 4) : (F.wave - 5)); for (int it = cw; it < CONV_PRO; it += 896) conv_ordered(it, F.lane); }
    } else { phase_ada(F, F.gw, F.NGW); for (int it = F.gw; it < CONV_PRO; it += F.NGW) conv_ordered(it, F.lane); }
}

__device__ __forceinline__ float row_ss(const f32x4 (&v)[8]) { float s = 0.f;
#pragma unroll
    for (int jx = 0; jx < 8; ++jx) s += (v[jx][0] * v[jx][0] + v[jx][1] * v[jx][1]) + (v[jx][2] * v[jx][2] + v[jx][3] * v[jx][3]);
    return 1.0f / sqrtf(wave_sum(s) * (1.0f / D) + EPS); }
__device__ __forceinline__ void sample_row_fold(float* X, const float* PART, int row, int nsplit, int lane, f32x4 (&v)[8]) {
    f32x4* xr = (f32x4*)(X + (size_t)row * D) + lane;
#pragma unroll
    for (int jx = 0; jx < 8; ++jx) v[jx] = xr[64 * jx];
    if (nsplit > 0) {
        for (int ks = 0; ks < nsplit; ++ks) { const f32x4* pp = (const f32x4*)(PART + ((size_t)ks * 128 + (row - TP)) * D) + lane;
#pragma unroll
            for (int jx = 0; jx < 8; ++jx) v[jx] += pp[64 * jx]; }
#pragma unroll
        for (int jx = 0; jx < 8; ++jx) xr[64 * jx] = v[jx]; }
}
__device__ __forceinline__ void phase_norm(const Frame& F, int l, int which, int nsplit) {
    float* X = (float*)(WSP + WS_X); const float* PART = (const float*)(WSP + WS_PART); bf16* H = (bf16*)(WSP + WS_H); const float* MOD = (const float*)(WSP + WS_MOD);
    const float* nw = INP(I_NW) + (size_t)(l * 3 + which) * D; const float* mbase = MOD + (size_t)l * NMODW + (size_t)(3 * which) * D;
    LAS float* T = (LAS float*)F.lds;
    for (int i = F.tid; i < 4 * 512; i += NTHR) { const int b = i >> 9, c4 = (i & 511) * 4; const f32x4 w = *(const f32x4*)(nw + c4), sh = *(const f32x4*)(mbase + (size_t)b * MODLD + c4), sc = *(const f32x4*)(mbase + (size_t)b * MODLD + D + c4);
        *(LAS f32x4*)(T + (b * 2) * 2048 + c4) = w * (sc + 1.0f); *(LAS f32x4*)(T + (b * 2 + 1) * 2048 + c4) = sh; }
    if (F.gw < TS) { const int row = TP + F.gw; f32x4 v[8]; sample_row_fold(X, PART, row, nsplit, F.lane, v); const float rs = row_ss(v);
        const float* mp = mbase + (size_t)(4 + F.gw) * MODLD; u32x2* hp = (u32x2*)(H + (size_t)row * D) + F.lane;
#pragma unroll
        for (int jx = 0; jx < 8; ++jx) { const int c = 4 * (F.lane + 64 * jx); const f32x4 w = *(const f32x4*)(nw + c), sh = *(const f32x4*)(mp + c), sc = *(const f32x4*)(mp + D + c);
            const f32x4 h = (v[jx] * rs) * w * (sc + 1.0f) + sh; u32x2 o; o.x = cvt_pk_bf16(h[0], h[1]); o.y = cvt_pk_bf16(h[2], h[3]); hp[64 * jx] = o; } }
    __syncthreads();
    for (int row = F.gw; row < TP; row += 2 * F.NGW) { const int rowb = row + F.NGW; const bool hasb = rowb < TP;
        const f32x4* xa = (const f32x4*)(X + (size_t)row * D) + F.lane; const f32x4* xb = (const f32x4*)(X + (size_t)(hasb ? rowb : row) * D) + F.lane; f32x4 va[8], vb[8];
#pragma unroll
        for (int jx = 0; jx < 8; ++jx) { va[jx] = xa[64 * jx]; vb[jx] = xb[64 * jx]; }
        const float ra = row_ss(va), rb = row_ss(vb);
        const LAS float* ta = T + ((row >> 11) * 2) * 2048; const LAS float* tb = T + (((hasb ? rowb : row) >> 11) * 2) * 2048;
        u32x2* ha = (u32x2*)(H + (size_t)row * D) + F.lane; u32x2* hb = (u32x2*)(H + (size_t)rowb * D) + F.lane;
#pragma unroll
        for (int jx = 0; jx < 8; ++jx) { const int c = 4 * (F.lane + 64 * jx);
            const f32x4 h = (va[jx] * ra) * *(const LAS f32x4*)(ta + c) + *(const LAS f32x4*)(ta + 2048 + c); u32x2 o; o.x = cvt_pk_bf16(h[0], h[1]); o.y = cvt_pk_bf16(h[2], h[3]); ha[64 * jx] = o;
            if (hasb) { const f32x4 g = (vb[jx] * rb) * *(const LAS f32x4*)(tb + c) + *(const LAS f32x4*)(tb + 2048 + c); u32x2 q; q.x = cvt_pk_bf16(g[0], g[1]); q.y = cvt_pk_bf16(g[2], g[3]); hb[64 * jx] = q; } }
    }
    __syncthreads();
}
__device__ __forceinline__ void phase_final(const Frame& F, int nsplit) {
    float* X = (float*)(WSP + WS_X); const float* PART = (const float*)(WSP + WS_PART); const float* fw = INP(I_FNW); float* out = OUTP + O_Y;
    if (F.gw < TS) { const int row = TP + F.gw; f32x4 v[8]; sample_row_fold(X, PART, row, nsplit, F.lane, v); const float rs = row_ss(v); f32x4* op = (f32x4*)(out + (size_t)row * D) + F.lane;
#pragma unroll
        for (int jx = 0; jx < 8; ++jx) { const f32x4 w = *(const f32x4*)(fw + 4 * (F.lane + 64 * jx)); op[64 * jx] = (v[jx] * rs) * w; } }
    for (int row = F.gw; row < TP; row += F.NGW) {
        const f32x4* xr = (const f32x4*)(X + (size_t)row * D) + F.lane; f32x4 v[8];
#pragma unroll
        for (int jx = 0; jx < 8; ++jx) v[jx] = xr[64 * jx];
        const float rs = row_ss(v); f32x4* op = (f32x4*)(out + (size_t)row * D) + F.lane;
#pragma unroll
        for (int jx = 0; jx < 8; ++jx) { const f32x4 w = *(const f32x4*)(fw + 4 * (F.lane + 64 * jx)); op[64 * jx] = (v[jx] * rs) * w; }
    }
}

__device__ __forceinline__ void s5_params(int j, int g, int n, float& ar, float& ai, float (&bbr)[16], float (&bbi)[16]) {
    const float step = expf(INP(I_LSTEP)[j * 64 + g]); const int gi = (j * 64 + g) * 64 + n;
    const float lr = INP(I_LAMRE)[gi], li = INP(I_LAMIM)[gi], mag = expf(lr * step); float sn, cs; sincos_acc(li * step, sn, cs);
    ar = mag * cs; ai = mag * sn;
    const float den = lr * lr + li * li, pr = ar - 1.0f, pim = ai, zr = (pr * lr + pim * li) / den, zi = (pim * lr - pr * li) / den;
    const f32x4* br = (const f32x4*)(INP(I_BRE) + (size_t)gi * 16); const f32x4* bi = (const f32x4*)(INP(I_BIM) + (size_t)gi * 16);
#pragma unroll
    for (int q = 0; q < 4; ++q) { const f32x4 r4 = br[q], i4 = bi[q];
#pragma unroll
        for (int e = 0; e < 4; ++e) { bbr[4 * q + e] = zr * r4[e] - zi * i4[e]; bbi[4 * q + e] = zr * i4[e] + zi * r4[e]; } }
}
__device__ __forceinline__ void s5_load_u(const bf16* Z, int row0, int g, LAS float* ut, int lane) {
    const u32x4* p = (const u32x4*)(Z + (size_t)(row0 + lane) * DIN + g * 16); const u32x4 w0 = p[0], w1 = p[1];
    LAS f32x4* o = (LAS f32x4*)(ut + lane * 16);
    o[0] = (f32x4){bflo(w0.x), bfhi(w0.x), bflo(w0.y), bfhi(w0.y)}; o[1] = (f32x4){bflo(w0.z), bfhi(w0.z), bflo(w0.w), bfhi(w0.w)};
    o[2] = (f32x4){bflo(w1.x), bfhi(w1.x), bflo(w1.y), bfhi(w1.y)}; o[3] = (f32x4){bflo(w1.z), bfhi(w1.z), bflo(w1.w), bfhi(w1.w)};
    asm volatile("s_waitcnt lgkmcnt(0)" ::: "memory");
}
#define S5_STEP(utrow) do { const LAS f32x4* _u = (const LAS f32x4*)(utrow); const f32x4 u0 = _u[0], u1 = _u[1], u2 = _u[2], u3 = _u[3]; float xr = 0.f, xi = 0.f; \
    _Pragma("unroll") for (int e = 0; e < 4; ++e) { xr = fmaf(bbr[e], u0[e], xr); xi = fmaf(bbi[e], u0[e], xi); xr = fmaf(bbr[4 + e], u1[e], xr); xi = fmaf(bbi[4 + e], u1[e], xi); \
        xr = fmaf(bbr[8 + e], u2[e], xr); xi = fmaf(bbi[8 + e], u2[e], xi); xr = fmaf(bbr[12 + e], u3[e], xr); xi = fmaf(bbi[12 + e], u3[e], xi); } \
    const float nr = fmaf(ar, hr, fmaf(-ai, hi, xr)), ni = fmaf(ar, hi, fmaf(ai, hr, xi)); hr = nr; hi = ni; } while (0)

__device__ __forceinline__ void s5_sample(const Frame& F, int j) {
    const bf16* Z = (const bf16*)(WSP + WS_Z); bf16* YA = (bf16*)(WSP + WS_YA);
    LAS float* hb = (LAS float*)(F.lds + F.wave * 4096);
    for (int item = F.vcu; item < 256; item += F.G) { const int g = item >> 2, bq = item & 3, n = F.lane;
        float ar, ai, bbr[16], bbi[16]; s5_params(j, g, n, ar, ai, bbr, bbi);
        for (int i = 0; i < 4; ++i) { const int b = bq * 32 + F.wave * 4 + i, row = TP + b;
            const u32x4* p = (const u32x4*)(Z + (size_t)row * DIN + g * 16); const u32x4 w0 = p[0], w1 = p[1];
            float u[16] = {bflo(w0.x), bfhi(w0.x), bflo(w0.y), bfhi(w0.y), bflo(w0.z), bfhi(w0.z), bflo(w0.w), bfhi(w0.w), bflo(w1.x), bfhi(w1.x), bflo(w1.y), bfhi(w1.y), bflo(w1.z), bfhi(w1.z), bflo(w1.w), bfhi(w1.w)};
            const size_t si = (size_t)((j * 128 + b) * 64 + g) * 64 + n; const float h0r = INP(I_S5RE)[si], h0i = INP(I_S5IM)[si];
            float xr = 0.f, xi = 0.f;
#pragma unroll
            for (int e = 0; e < 16; ++e) { xr = fmaf(bbr[e], u[e], xr); xi = fmaf(bbi[e], u[e], xi); }
            const float hr = ar * h0r - ai * h0i + xr, hi = ar * h0i + ai * h0r + xi;
            OUTP[O_SS5R + si] = hr; OUTP[O_SS5I + si] = hi;
            hb[n] = hr; hb[64 + n] = hi; asm volatile("s_waitcnt lgkmcnt(0)" ::: "memory");
            if (n < 16) { const float* cr = INP(I_CRE) + (size_t)((j * 64 + g) * 16 + n) * 64; const float* ci = INP(I_CIM) + (size_t)((j * 64 + g) * 16 + n) * 64; float y = 0.f;
                for (int q = 0; q < 64; ++q) y += hb[q] * cr[q] - hb[64 + q] * ci[q];
                float uk = 0.f;
#pragma unroll
                for (int e = 0; e < 16; ++e) uk = (n == e) ? u[e] : uk;
                y += INP(I_S5D)[j * 1024 + g * 16 + n] * uk;
                YA[(size_t)row * DA + g * 16 + n] = (bf16)(cvt_pk_bf16(fgelu(y), 0.f) & 0xffffu); }
            asm volatile("s_waitcnt lgkmcnt(0)" ::: "memory");
        }
    }
}
typedef short bf16x4 __attribute__((ext_vector_type(4)));
__device__ __forceinline__ void s5_disc(int j, int g, int n, float& ar, float& ai, float& zr, float& zi) {
    const float step = expf(INP(I_LSTEP)[j * 64 + g]); const int gi = (j * 64 + g) * 64 + n;
    const float lr = INP(I_LAMRE)[gi], li = INP(I_LAMIM)[gi], mag = expf(lr * step); float sn, cs; sincos_acc(li * step, sn, cs);
    ar = mag * cs; ai = mag * sn; const float den = lr * lr + li * li, pr = ar - 1.0f, pim = ai; zr = (pr * lr + pim * li) / den; zi = (pim * lr - pr * li) / den;
}
__device__ __forceinline__ void s5_fused(const Frame& F, int j) {
    unsigned char* ws = WSP; const bf16* Z = (const bf16*)(ws + WS_Z); bf16* YA = (bf16*)(ws + WS_YA);
    LAS float* X2 = (LAS float*)(F.lds + F.wave * 14592);
    LAS unsigned char* Hb = F.lds + F.wave * 14592 + 10240;
    LAS float* EX = (LAS float*)(F.lds + 8 * 14592);
    const int n = F.lane, r = F.lane & 15, kq = F.lane >> 4, c = F.wave;
    for (int item = F.vcu; item < 256; item += F.G) { const int b = item >> 6, g = item & 63, row0 = b * 2048 + c * 256;
        float ar, ai, zr0, zi0; s5_disc(j, g, n, ar, ai, zr0, zi0);
        bf16x4 bre[4], bim[4];
#pragma unroll
        for (int st = 0; st < 4; ++st) { const int ns = st * 16 + r; float a0, a1, zr, zi; s5_disc(j, g, ns, a0, a1, zr, zi); const size_t bo = (size_t)((j * 64 + g) * 64 + ns) * 16 + 4 * kq;
            const f32x4 br = *(const f32x4*)(INP(I_BRE) + bo), bi = *(const f32x4*)(INP(I_BIM) + bo); const f32x4 xr = br * zr - bi * zi, xi = bi * zr + br * zi;
            u32x2 pr; pr.x = cvt_pk_bf16(xr[0], xr[1]); pr.y = cvt_pk_bf16(xr[2], xr[3]); u32x2 pi; pi.x = cvt_pk_bf16(xi[0], xi[1]); pi.y = cvt_pk_bf16(xi[2], xi[3]);
            bre[st] = __builtin_bit_cast(bf16x4, pr); bim[st] = __builtin_bit_cast(bf16x4, pi); }
        u32x2 uf[16];
#pragma unroll
        for (int blk = 0; blk < 16; ++blk) uf[blk] = *(const u32x2*)(Z + (size_t)(row0 + blk * 16 + r) * DIN + g * 16 + 4 * kq);
        const f32x4 zero4 = (f32x4){0.f, 0.f, 0.f, 0.f};
#define S5_XBLK(blk) do { const bf16x4 ua = __builtin_bit_cast(bf16x4, uf[blk]); \
            _Pragma("unroll") for (int st = 0; st < 4; ++st) { const f32x4 xr4 = __builtin_amdgcn_mfma_f32_16x16x16bf16_1k(ua, bre[st], zero4, 0, 0, 0), xi4 = __builtin_amdgcn_mfma_f32_16x16x16bf16_1k(ua, bim[st], zero4, 0, 0, 0); \
                *(LAS f32x4*)(X2 + (st * 16 + r) * 20 + 4 * kq) = xr4; *(LAS f32x4*)(X2 + (64 + st * 16 + r) * 20 + 4 * kq) = xi4; } \
            asm volatile("s_waitcnt lgkmcnt(0)" ::: "memory"); } while (0)
        float hr = 0.f, hi = 0.f;
#pragma unroll
        for (int blk = 0; blk < 16; ++blk) { S5_XBLK(blk);
#pragma unroll
            for (int q = 0; q < 4; ++q) { const f32x4 xr4 = *(const LAS f32x4*)(X2 + n * 20 + 4 * q), xi4 = *(const LAS f32x4*)(X2 + (64 + n) * 20 + 4 * q);
#pragma unroll
                for (int e = 0; e < 4; ++e) { const float nr = fmaf(ar, hr, fmaf(-ai, hi, xr4[e])), ni = fmaf(ar, hi, fmaf(ai, hr, xi4[e])); hr = nr; hi = ni; } }
            asm volatile("s_waitcnt lgkmcnt(0)" ::: "memory"); }
        __syncthreads();
        EX[c * 128 + n] = hr; EX[c * 128 + 64 + n] = hi;
        __syncthreads();
        float pr = ar, pi = ai;
#pragma unroll
        for (int q = 0; q < 8; ++q) { const float t0 = pr * pr - pi * pi, t1 = 2.0f * pr * pi; pr = t0; pi = t1; }
        hr = 0.f; hi = 0.f;
        for (int cc = 0; cc < c; ++cc) { const float er = EX[cc * 128 + n], ei = EX[cc * 128 + 64 + n]; const float nr = pr * hr - pi * hi + er, ni = pr * hi + pi * hr + ei; hr = nr; hi = ni; }
        pg8::bf16x8 ctf[4];
#pragma unroll
        for (int ks = 0; ks < 4; ++ks) { const int np0 = ks * 32 + kq * 8; const float* src = (np0 < 64 ? INP(I_CRE) : INP(I_CIM)) + (size_t)((j * 64 + g) * 16 + r) * 64 + (np0 & 63); const float sg = np0 < 64 ? 1.0f : -1.0f;
            const f32x4 c0 = *(const f32x4*)src * sg, c1 = *(const f32x4*)(src + 4) * sg; u32x4 o; o.x = cvt_pk_bf16(c0[0], c0[1]); o.y = cvt_pk_bf16(c0[2], c0[3]); o.z = cvt_pk_bf16(c1[0], c1[1]); o.w = cvt_pk_bf16(c1[2], c1[3]); ctf[ks] = __builtin_bit_cast(pg8::bf16x8, o); }
        const f32x4 dsk = *(const f32x4*)(INP(I_S5D) + j * 1024 + g * 16 + 4 * kq);
#pragma unroll
        for (int blk = 0; blk < 16; ++blk) { S5_XBLK(blk);
#pragma unroll
            for (int q = 0; q < 4; ++q) { const f32x4 xr4 = *(const LAS f32x4*)(X2 + n * 20 + 4 * q), xi4 = *(const LAS f32x4*)(X2 + (64 + n) * 20 + 4 * q);
#pragma unroll
                for (int e = 0; e < 4; ++e) { const float nr = fmaf(ar, hr, fmaf(-ai, hi, xr4[e])), ni = fmaf(ar, hi, fmaf(ai, hr, xi4[e])); hr = nr; hi = ni;
                    const unsigned hw = cvt_pk_bf16(hr, hi); *(LAS unsigned short*)(Hb + (4 * q + e) * 272 + n * 2) = (unsigned short)(hw & 0xffffu); *(LAS unsigned short*)(Hb + (4 * q + e) * 272 + (64 + n) * 2) = (unsigned short)(hw >> 16); } }
            asm volatile("s_waitcnt lgkmcnt(0)" ::: "memory");
            f32x4 y = zero4;
#pragma unroll
            for (int ks = 0; ks < 4; ++ks) y = __builtin_amdgcn_mfma_f32_16x16x32_bf16(ctf[ks], *(const LAS pg8::bf16x8*)(Hb + r * 272 + ks * 64 + kq * 16), y, 0, 0, 0);
            y += dsk * (f32x4){bflo(uf[blk].x), bfhi(uf[blk].x), bflo(uf[blk].y), bfhi(uf[blk].y)};
            u32x2 wv; wv.x = cvt_pk_bf16(fgelu(y[0]), fgelu(y[1])); wv.y = cvt_pk_bf16(fgelu(y[2]), fgelu(y[3]));
            *(u32x2*)(YA + (size_t)(row0 + blk * 16 + r) * DA + g * 16 + 4 * kq) = wv;
            asm volatile("s_waitcnt lgkmcnt(0)" ::: "memory"); }
#undef S5_XBLK
        if (c == 7) { const size_t si = (size_t)((j * 4 + b) * 64 + g) * 64 + n; OUTP[O_PS5R + si] = hr; OUTP[O_PS5I + si] = hi; }
    }
    __syncthreads();
}

__device__ __forceinline__ pg8::bf16x8 lds_frag(const LAS unsigned char* base, int row, int stride, int kbyte) { return *(const LAS pg8::bf16x8*)(base + row * stride + kbyte); }
__device__ __forceinline__ void hgrn_h1(const Frame& F, int j) {
    unsigned char* ws = WSP; const bf16* Z = (const bf16*)(ws + WS_Z); float* OB = (float*)(ws + WS_OB); const float* LB = (const float*)(ws + WS_LB) + j * 1024;
    float* TT = (float*)(ws + WS_HT); bf16* QG = (bf16*)(ws + WS_QG); float* HD = (float*)(ws + WS_HD);
    LAS unsigned char* QT = F.lds; LAS unsigned char* KT = QT + 17408; LAS unsigned char* KHT = KT + 17408; LAS unsigned char* VT = KHT + 18432; LAS unsigned char* PT = VT + 18432; LAS float* SEG = (LAS float*)(PT + 9216);
    const int col = F.tid & 127, seg = F.tid >> 7, t0 = seg * 16, r = F.lane & 15, kq = F.lane >> 4, w = F.wave;
    for (int item = F.vcu; item < 1024; item += F.G) { const int b = item >> 8, c = (item >> 3) & 31, h = item & 7, row0 = b * 2048 + c * 64;
        const bf16* zq = Z + (size_t)(row0 + t0) * DIN + 1024 + h * 128 + col; const float lb = LB[h * 128 + col];
        float q[16], kk[16], g[16]; unsigned short vr[16];
#pragma unroll
        for (int i = 0; i < 16; ++i) { const float qv = __uint_as_float((unsigned)zq[(size_t)i * DIN] << 16), fz = __uint_as_float((unsigned)zq[(size_t)i * DIN + 1024] << 16); vr[i] = zq[(size_t)i * DIN + 2048];
            const float s = fsigmoid(fz), f = lb + (1.0f - lb) * s; q[i] = qv; kk[i] = (1.0f - lb) * (1.0f - s); g[i] = __logf(f); }
#pragma unroll
        for (int i = 1; i < 16; ++i) g[i] += g[i - 1];
        __syncthreads();
        SEG[seg * 128 + col] = g[15];
        __syncthreads();
        const float s0 = SEG[col], s1 = SEG[128 + col], s2 = SEG[256 + col], s3 = SEG[384 + col];
        const float pre = seg == 0 ? 0.f : seg == 1 ? s0 : seg == 2 ? s0 + s1 : s0 + s1 + s2, Gm = s0 + s1, Gl = (s0 + s1) + (s2 + s3);
        unsigned khb[8];
#pragma unroll
        for (int i = 0; i < 16; ++i) { const float G = pre + g[i]; const float qt = q[i] * __expf(G - Gm), kt = kk[i] * __expf(Gm - G), kh = kk[i] * __expf(Gl - G), qg = q[i] * __expf(G);
            const unsigned p0 = cvt_pk_bf16(qt, kt), p1 = cvt_pk_bf16(kh, qg);
            *(LAS unsigned short*)(QT + (t0 + i) * 272 + col * 2) = (unsigned short)(p0 & 0xffffu); *(LAS unsigned short*)(KT + (t0 + i) * 272 + col * 2) = (unsigned short)(p0 >> 16);
            QG[((size_t)item * 64 + t0 + i) * 128 + col] = (bf16)(p1 >> 16);
            if (i & 1) khb[i >> 1] |= (p1 & 0xffffu) << 16; else khb[i >> 1] = p1 & 0xffffu; }
        *(LAS u32x4*)(KHT + col * 144 + t0 * 2) = (u32x4){khb[0], khb[1], khb[2], khb[3]}; *(LAS u32x4*)(KHT + col * 144 + t0 * 2 + 16) = (u32x4){khb[4], khb[5], khb[6], khb[7]};
        *(LAS u32x4*)(VT + col * 144 + t0 * 2) = (u32x4){(unsigned)vr[0] | ((unsigned)vr[1] << 16), (unsigned)vr[2] | ((unsigned)vr[3] << 16), (unsigned)vr[4] | ((unsigned)vr[5] << 16), (unsigned)vr[6] | ((unsigned)vr[7] << 16)};
        *(LAS u32x4*)(VT + col * 144 + t0 * 2 + 16) = (u32x4){(unsigned)vr[8] | ((unsigned)vr[9] << 16), (unsigned)vr[10] | ((unsigned)vr[11] << 16), (unsigned)vr[12] | ((unsigned)vr[13] << 16), (unsigned)vr[14] | ((unsigned)vr[15] << 16)};
        if (seg == 0) HD[(size_t)item * 128 + col] = __expf(Gl);
        __syncthreads();
        { const int tt = w & 3;
#pragma unroll
          for (int u = 0; u < 2; ++u) { const int st = 2 * (w >> 2) + u; f32x4 acc = (f32x4){0.f, 0.f, 0.f, 0.f};
              if (st <= tt) {
#pragma unroll
                  for (int ks = 0; ks < 4; ++ks) acc = __builtin_amdgcn_mfma_f32_16x16x32_bf16(lds_frag(KT, st * 16 + r, 272, ks * 64 + kq * 16), lds_frag(QT, tt * 16 + r, 272, ks * 64 + kq * 16), acc, 0, 0, 0); }
              const int t = tt * 16 + r, sb = st * 16 + 4 * kq;
              u32x2 pw; pw.x = cvt_pk_bf16(sb <= t ? acc[0] : 0.f, sb + 1 <= t ? acc[1] : 0.f); pw.y = cvt_pk_bf16(sb + 2 <= t ? acc[2] : 0.f, sb + 3 <= t ? acc[3] : 0.f);
              *(LAS u32x2*)(PT + t * 144 + sb * 2) = pw; } }
        __syncthreads();
        { const int tt = w & 3; const pg8::bf16x8 p0 = lds_frag(PT, tt * 16 + r, 144, kq * 16), p1 = lds_frag(PT, tt * 16 + r, 144, 64 + kq * 16);
#pragma unroll
          for (int u = 0; u < 4; ++u) { const int vt = 4 * (w >> 2) + u; f32x4 acc = (f32x4){0.f, 0.f, 0.f, 0.f};
              acc = __builtin_amdgcn_mfma_f32_16x16x32_bf16(lds_frag(VT, vt * 16 + r, 144, kq * 16), p0, acc, 0, 0, 0); acc = __builtin_amdgcn_mfma_f32_16x16x32_bf16(lds_frag(VT, vt * 16 + r, 144, 64 + kq * 16), p1, acc, 0, 0, 0);
              *(f32x4*)(OB + (size_t)(row0 + tt * 16 + r) * 1024 + h * 128 + vt * 16 + 4 * kq) = acc; } }
        { const int vt = w; const pg8::bf16x8 v0 = lds_frag(VT, vt * 16 + r, 144, kq * 16), v1 = lds_frag(VT, vt * 16 + r, 144, 64 + kq * 16);
#pragma unroll
          for (int kt = 0; kt < 8; ++kt) { f32x4 acc = (f32x4){0.f, 0.f, 0.f, 0.f};
              acc = __builtin_amdgcn_mfma_f32_16x16x32_bf16(lds_frag(KHT, kt * 16 + r, 144, kq * 16), v0, acc, 0, 0, 0); acc = __builtin_amdgcn_mfma_f32_16x16x32_bf16(lds_frag(KHT, kt * 16 + r, 144, 64 + kq * 16), v1, acc, 0, 0, 0);
              *(f32x4*)(TT + ((size_t)item * 128 + vt * 16 + r) * 128 + kt * 16 + 4 * kq) = acc; } }
    }
    __syncthreads();
}
__device__ __forceinline__ void hgrn_h2(const Frame& F, int j) {
    unsigned char* ws = WSP; const float* TT = (const float*)(ws + WS_HT); const float* HD = (const float*)(ws + WS_HD); bf16* HS = (bf16*)(ws + WS_HS);
    for (int e = F.gt; e < 32 * 128 * 32; e += F.NT) { const int bh = e >> 12, v = (e >> 5) & 127, k4 = (e & 31) * 4, b = bh >> 3, h = bh & 7;
        f32x4 S = (f32x4){0.f, 0.f, 0.f, 0.f};
#pragma unroll 4
        for (int c = 0; c < 32; ++c) { const size_t item = (size_t)(b * 32 + c) * 8 + h; const size_t o = (item * 128 + v) * 128 + k4;
            u32x2 sw; sw.x = cvt_pk_bf16(S[0], S[1]); sw.y = cvt_pk_bf16(S[2], S[3]); *(u32x2*)(HS + o) = sw;
            const f32x4 T = *(const f32x4*)(TT + o), Dv = *(const f32x4*)(HD + item * 128 + k4); S = Dv * S + T; }
        float* op = OUTP + O_PHG + ((size_t)((j * 4 + b) * 8 + h) * 128 + k4) * 128 + v;
#pragma unroll
        for (int q = 0; q < 4; ++q) op[(size_t)q * 128] = S[q]; }
}
__device__ __forceinline__ void hgrn_h3(const Frame& F, int j) {
    unsigned char* ws = WSP; const bf16* Z = (const bf16*)(ws + WS_Z); bf16* MIX = (bf16*)(ws + WS_MIX); const float* OB = (const float*)(ws + WS_OB); const bf16* QG = (const bf16*)(ws + WS_QG); const bf16* HS = (const bf16*)(ws + WS_HS);
    const int half = F.wave >> 2, tt = F.wave & 3, r = F.lane & 15, kq = F.lane >> 4;
    for (int it2 = F.vcu * 2; it2 < 1024; it2 += 2 * F.G) { const int item = it2 + half, b = item >> 8, c = (item >> 3) & 31, h = item & 7, row = b * 2048 + c * 64 + tt * 16 + r;
        pg8::bf16x8 qf[4];
#pragma unroll
        for (int ks = 0; ks < 4; ++ks) qf[ks] = *(const pg8::bf16x8*)(QG + ((size_t)item * 64 + tt * 16 + r) * 128 + ks * 32 + kq * 8);
        f32x4 o[8]; float ss = 0.f;
#pragma unroll
        for (int vt = 0; vt < 8; ++vt) { f32x4 acc = *(const f32x4*)(OB + (size_t)row * 1024 + h * 128 + vt * 16 + 4 * kq);
#pragma unroll
            for (int ks = 0; ks < 4; ++ks) acc = __builtin_amdgcn_mfma_f32_16x16x32_bf16(*(const pg8::bf16x8*)(HS + ((size_t)item * 128 + vt * 16 + r) * 128 + ks * 32 + kq * 8), qf[ks], acc, 0, 0, 0);
            o[vt] = acc; ss += (acc[0] * acc[0] + acc[1] * acc[1]) + (acc[2] * acc[2] + acc[3] * acc[3]); }
        ss += swz_xor16(ss); ss += __int_as_float(__builtin_amdgcn_ds_bpermute((F.lane ^ 32) << 2, __float_as_int(ss)));
        const float rs = 1.0f / sqrtf(ss * (1.0f / 128.0f) + EPS);
#pragma unroll
        for (int vt = 0; vt < 8; ++vt) { const int cv = h * 128 + vt * 16 + 4 * kq; const u32x2 gv = *(const u32x2*)(Z + (size_t)row * DIN + 4096 + cv); const f32x4 gw = *(const f32x4*)(INP(I_HGNW) + j * 128 + vt * 16 + 4 * kq);
            u32x2 y; y.x = cvt_pk_bf16(o[vt][0] * rs * gw[0] * fsilu(bflo(gv.x)), o[vt][1] * rs * gw[1] * fsilu(bfhi(gv.x))); y.y = cvt_pk_bf16(o[vt][2] * rs * gw[2] * fsilu(bflo(gv.y)), o[vt][3] * rs * gw[3] * fsilu(bfhi(gv.y)));
            *(u32x2*)(MIX + (size_t)row * D + 1024 + cv) = y; }
    }
}
__device__ __forceinline__ void hgrn_sample(const Frame& F, int j) {
    const bf16* Z = (const bf16*)(WSP + WS_Z); bf16* MIX = (bf16*)(WSP + WS_MIX); const float* LB = (const float*)(WSP + WS_LB) + j * 1024;
    LAS float* fb = (LAS float*)F.lds; LAS float* kb = fb + 128; LAS float* qb = kb + 128; LAS float* vb = qb + 128; LAS float* gb = vb + 128; LAS float* red = gb + 128; LAS float* POL = red + 128;
    const int tid = F.tid, v4 = (tid & 31) * 4, kq = tid >> 5;
    for (int item = F.vcu; item < 1024; item += F.G) { const int b = item >> 3, h = item & 7, row = TP + b;
        __syncthreads();
        if (tid < 128) { const bf16* zr = Z + (size_t)row * DIN + h * 128 + tid; const float lb = LB[h * 128 + tid];
            const float q = __uint_as_float((unsigned)zr[1024] << 16), fz = __uint_as_float((unsigned)zr[2048] << 16), iv = __uint_as_float((unsigned)zr[3072] << 16), g = __uint_as_float((unsigned)zr[4096] << 16);
            const float s = fsigmoid(fz); fb[tid] = lb + (1.0f - lb) * s; kb[tid] = (1.0f - lb) * (1.0f - s); qb[tid] = q; vb[tid] = iv; gb[tid] = g; }
        __syncthreads();
        const f32x4 vv = *(const LAS f32x4*)(vb + v4); f32x4 po = (f32x4){0.f, 0.f, 0.f, 0.f};
        const size_t sbase = (size_t)((j * 128 + b) * 8 + h) * 128 * 128;
#pragma unroll
        for (int i = 0; i < 8; ++i) { const int k = kq + 16 * i; const f32x4 s0 = *(const f32x4*)(INP(I_HG) + sbase + (size_t)k * 128 + v4);
            const f32x4 s1 = s0 * fb[k] + vv * kb[k]; *(f32x4*)(OUTP + O_SHG + sbase + (size_t)k * 128 + v4) = s1; po += s1 * qb[k]; }
        *(LAS f32x4*)(POL + kq * 128 + v4) = po;
        __syncthreads();
        float o = 0.f;
        if (tid < 128) {
#pragma unroll
            for (int i = 0; i < 16; ++i) o += POL[i * 128 + tid];
            const float ss = wave_sum(o * o); if (F.lane == 0) red[F.wave] = ss; }
        __syncthreads();
        if (tid < 128) { const float rs = 1.0f / sqrtf((red[0] + red[1]) * (1.0f / 128.0f) + EPS); const float y = o * rs * INP(I_HGNW)[j * 128 + tid] * fsilu(gb[tid]);
            MIX[(size_t)row * D + 1024 + h * 128 + tid] = (bf16)(cvt_pk_bf16(y, 0.f) & 0xffffu); }
    }
    __syncthreads();
}
__device__ __forceinline__ void unpack8(const u32x4 w, float (&x)[8]) { x[0] = bflo(w.x); x[1] = bfhi(w.x); x[2] = bflo(w.y); x[3] = bfhi(w.y); x[4] = bflo(w.z); x[5] = bfhi(w.z); x[6] = bflo(w.w); x[7] = bfhi(w.w); }
__device__ __forceinline__ void lru_conv(const Frame& F, int j) {
    const bf16* XR = (const bf16*)(WSP + WS_XR); bf16* XCB = (bf16*)(WSP + WS_XCB);
    const float* cw = INP(I_CONVW) + (size_t)j * 4 * DRNN; const float* cb = INP(I_CONVB) + (size_t)j * DRNN;
    for (int i = F.gt; i < TT * 320; i += F.NT) { const int row = i / 320, c8 = (i % 320) * 8;
        float x0[8], x1[8], x2[8], x3[8]; unpack8(*(const u32x4*)(XR + (size_t)row * DRNN + c8), x3);
        if (row < TP) { const int t = row & 2047, b = row >> 11; const u32x4 z = (u32x4){0u, 0u, 0u, 0u};
            unpack8(t >= 1 ? *(const u32x4*)(XR + (size_t)(row - 1) * DRNN + c8) : z, x2); unpack8(t >= 2 ? *(const u32x4*)(XR + (size_t)(row - 2) * DRNN + c8) : z, x1); unpack8(t >= 3 ? *(const u32x4*)(XR + (size_t)(row - 3) * DRNN + c8) : z, x0);
            if (t >= 2045) { float* op = OUTP + O_PCONV + (size_t)((j * 4 + b) * 3 + (t - 2045)) * DRNN + c8; *(f32x4*)op = (f32x4){x3[0], x3[1], x3[2], x3[3]}; *(f32x4*)(op + 4) = (f32x4){x3[4], x3[5], x3[6], x3[7]}; }
        } else { const int b = row - TP; const float* cbuf = INP(I_CONV) + (size_t)(j * 128 + b) * 3 * DRNN + c8; float* ob = OUTP + O_SCONV + (size_t)(j * 128 + b) * 3 * DRNN + c8;
#pragma unroll
            for (int e = 0; e < 8; ++e) { x0[e] = cbuf[e]; x1[e] = cbuf[DRNN + e]; x2[e] = cbuf[2 * DRNN + e]; ob[e] = x1[e]; ob[DRNN + e] = x2[e]; ob[2 * DRNN + e] = x3[e]; } }
        float xc[8];
#pragma unroll
        for (int e = 0; e < 8; ++e) xc[e] = cb[c8 + e] + x0[e] * cw[c8 + e] + x1[e] * cw[DRNN + c8 + e] + x2[e] * cw[2 * DRNN + c8 + e] + x3[e] * cw[3 * DRNN + c8 + e];
        u32x4 w; w.x = cvt_pk_bf16(xc[0], xc[1]); w.y = cvt_pk_bf16(xc[2], xc[3]); w.z = cvt_pk_bf16(xc[4], xc[5]); w.w = cvt_pk_bf16(xc[6], xc[7]); *(u32x4*)(XCB + (size_t)row * DRNN + c8) = w; }
}
__device__ __forceinline__ void lru_scan1(const Frame& F) {
    const unsigned* AB = (const unsigned*)(WSP + WS_AA); float* P = (float*)(WSP + WS_LRUP);
    for (int i = F.gt; i < 4 * 16 * 1280; i += F.NT) { const int cp = i % 1280, bc = i / 1280; const size_t base = (size_t)(bc * 128) * DRNN + 2 * cp;
        f32x2 L = (f32x2){0.f, 0.f}, Bv = (f32x2){0.f, 0.f};
#pragma unroll 8
        for (int t = 0; t < 128; ++t) { const u32x2 w = *(const u32x2*)(AB + base + (size_t)t * DRNN); const f32x2 la = (f32x2){bflo(w.x), bflo(w.y)}, bv = (f32x2){bfhi(w.x), bfhi(w.y)};
            L += la; Bv = (f32x2){__expf(la[0]), __expf(la[1])} * Bv + bv; }
        *(f32x4*)(P + (size_t)i * 4) = (f32x4){__expf(L[0]), __expf(L[1]), Bv[0], Bv[1]}; }
}
__device__ __forceinline__ void lru_scan2(const Frame& F, int j) {
    const unsigned* AB = (const unsigned*)(WSP + WS_AA); const float* P = (const float*)(WSP + WS_LRUP);
    const bf16* GB = (const bf16*)(WSP + WS_Z); bf16* MIX = (bf16*)(WSP + WS_MIX);
    for (int i = F.gt; i < 4 * 16 * 1280; i += F.NT) { const int cp = i % 1280, bc = i / 1280, c = bc & 15, b = bc >> 4; const size_t base = (size_t)(bc * 128) * DRNN + 2 * cp;
        f32x2 h = (f32x2){0.f, 0.f};
        for (int cc = 0; cc < c; ++cc) { const f32x4 pv = *(const f32x4*)(P + (size_t)((b * 16 + cc) * 1280 + cp) * 4); h = (f32x2){pv[0], pv[1]} * h + (f32x2){pv[2], pv[3]}; }
#pragma unroll 8
        for (int t = 0; t < 128; ++t) { const size_t o = base + (size_t)t * DRNN; const u32x2 w = *(const u32x2*)(AB + o); const unsigned gw = *(const unsigned*)(GB + o);
            h = (f32x2){__expf(bflo(w.x)), __expf(bflo(w.y))} * h + (f32x2){bfhi(w.x), bfhi(w.y)}; *(unsigned*)(MIX + o) = cvt_pk_bf16(bflo(gw) * h[0], bfhi(gw) * h[1]); }
        if (c == 15) *(f32x2*)(OUTP + O_PLRU + (size_t)(j * 4 + b) * DRNN + 2 * cp) = h; }
    for (int i = F.gt; i < TS * 1280; i += F.NT) { const int cp = i % 1280, b = i / 1280; const size_t o = (size_t)(TP + b) * DRNN + 2 * cp;
        const u32x2 w = *(const u32x2*)(AB + o); const f32x2 h0 = *(const f32x2*)(INP(I_LRU) + (size_t)(j * 128 + b) * DRNN + 2 * cp); const unsigned gw = *(const unsigned*)(GB + o);
        const f32x2 h = (f32x2){__expf(bflo(w.x)), __expf(bflo(w.y))} * h0 + (f32x2){bfhi(w.x), bfhi(w.y)}; *(f32x2*)(OUTP + O_SLRU + (size_t)(j * 128 + b) * DRNN + 2 * cp) = h; *(unsigned*)(MIX + o) = cvt_pk_bf16(bflo(gw) * h[0], bfhi(gw) * h[1]); }
}

#define GEMM_CALL(EpiT, OrdT, E, Aptr, Bptr, LDA, LDB, KK, NM, NN) do { pg8::Gemm g_{(const pg8::bf16_t*)(Aptr), (const pg8::bf16_t*)(Bptr), (LDA), (LDB), (KK)}; OrdT S_; S_.init((NM), (NN), F.G, F.bx); \
    pg8::gemm_phase<EpiT, OrdT, true, true>(F.lds, g_, S_, (E), F.tid); } while (0)
#define GEMM_RES(MODP, SCALE, Aptr, Bptr, LDK, NSPL) do { { EpiRes E{(float*)(ws + WS_X), (MODP), (SCALE)}; GEMM_CALL(EpiRes, pg8::StaticOrder, E, Aptr, Bptr, LDK, LDK, LDK, 32, 8); } \
    { EpiResPart E2{(float*)(ws + WS_PART), (MODP), (SCALE)}; pg8::Gemm g_{(const pg8::bf16_t*)(Aptr), (const pg8::bf16_t*)(Bptr), (LDK), (LDK), (LDK) / (NSPL)}; pg8::SplitKOrder S_; S_.init(32, 8, (NSPL), (LDK) / (NSPL), F.G, F.bx); \
      pg8::gemm_phase<EpiResPart, pg8::SplitKOrder, true, true>(F.lds, g_, S_, E2, F.tid); } } while (0)
__device__ __forceinline__ Frame make_frame(LAS unsigned char* lds, int wid) {
    Frame F; F.lds = lds; int ln = (int)__builtin_amdgcn_mbcnt_hi(~0u, __builtin_amdgcn_mbcnt_lo(~0u, 0u)); asm volatile("" : "+v"(ln)); int bx = blockIdx.x; asm volatile("" : "+s"(bx));
    F.lane = ln; F.wave = wid; F.tid = wid * 64 + ln; F.G = gridDim.x; F.bx = bx;
    F.vcu = (F.G % 8 == 0) ? (bx % 8) * (F.G / 8) + bx / 8 : bx;
    F.gw = F.vcu * NWAVES + F.wave; F.NGW = F.G * NWAVES; F.gt = F.vcu * NTHR + F.tid; F.NT = F.G * NTHR; return F;
}
__global__ void __launch_bounds__(NTHR, 2) fwd_kernel(Args a_unused) {
    extern __shared__ __attribute__((aligned(16))) unsigned char lds_raw[];
    LAS unsigned char* const lds = (LAS unsigned char*)lds_raw;
    volatile LAS unsigned* MISC = (volatile LAS unsigned*)(lds + MISC_OFF);
    for (int u = threadIdx.x; u < (LDS_BYTES - 131072) / 4; u += NTHR) ((LAS unsigned*)(lds + 131072))[u] = 0u;
    __syncthreads();
    int wid0 = __builtin_amdgcn_readfirstlane((int)threadIdx.x >> 6); asm volatile("" : "+s"(wid0)); const int wid = wid0;
    XcdBarrier bar = xcd_barrier_post((unsigned*)(WSP + WS_CTL) + CW_BAR, MISC + 8, wid);
    const int lo = (int)(unsigned)kargs()[N_IN + 2], hi = (int)(unsigned)(kargs()[N_IN + 2] >> 32); int ph = 0;
#define PH_BEGIN if (ph >= lo && ph < hi) { const Frame F = make_frame(lds, wid); unsigned char* const ws = WSP;
#define PH_END } if (ph >= lo && ph + 1 < hi) xcd_barrier(bar); ++ph;

    PH_BEGIN phase_prologue(F); PH_END
    PH_BEGIN phase_ada_conv(F); PH_END

    for (int l = 0; l < 4; ++l) {
        const int j = l >> 1;
#define MODL ((const float*)(ws + WS_MOD) + (size_t)l * NMODW)
        for (int s = 0; s < 2; ++s) {
            if (s == 1) {
                PH_BEGIN phase_norm(F, l, 1, 7); PH_END
                if ((l & 1) == 0) {
                    PH_BEGIN { EpiBf16 E{(bf16*)(ws + WS_Z), DIN}; GEMM_CALL(EpiBf16, pg8::StaticOrder, E, ws + WS_H, ws + WS_WINAB + (size_t)j * 5120 * 2048 * 2, 2048, 2048, 2048, NPAN, 20); conv_slot(F, l, 1, 148); } PH_END
                    PH_BEGIN s5_sample(F, j); __syncthreads(); hgrn_h1(F, j); hgrn_sample(F, j); PH_END
                    PH_BEGIN hgrn_h2(F, j); s5_fused(F, j); PH_END
                    PH_BEGIN hgrn_h3(F, j); PH_END
                    PH_BEGIN { EpiGlu E{(bf16*)(ws + WS_MIX), (const bf16*)(ws + WS_YA), INP(I_BGLU) + j * 1024}; GEMM_CALL(EpiGlu, pg8::StaticOrder, E, ws + WS_YA, ws + WS_WGLU + (size_t)j * 1024 * 1024 * 2, 1024, 1024, 1024, NPAN, 4); } PH_END
                    PH_BEGIN GEMM_RES(MODL + 5 * D, 1.0f, ws + WS_MIX, ws + WS_WOUTAB + (size_t)j * 2048 * 2048 * 2, 2048, 4); PH_END
                } else {
                    PH_BEGIN { EpiInC E{(bf16*)(ws + WS_Z), (bf16*)(ws + WS_XR)}; GEMM_CALL(EpiInC, pg8::StaticOrder, E, ws + WS_H, ws + WS_WINC + (size_t)j * 5120 * 2048 * 2, 2048, 2048, 2048, NPAN, 20); conv_slot(F, l, 1, 148); } PH_END
                    PH_BEGIN lru_conv(F, j); PH_END
                    PH_BEGIN { EpiGate E{(unsigned*)(ws + WS_AA), (const bf16*)(ws + WS_XCB), INP(I_BGA) + j * DRNN, INP(I_BGX) + j * DRNN, (const float*)(ws + WS_LL) + j * DRNN};
                               GEMM_CALL(EpiGate, pg8::GateOrder, E, ws + WS_XCB, ws + WS_WGATE + (size_t)j * 5120 * 2560 * 2, 2560, 2560, 384, NPAN, 20); } PH_END
                    PH_BEGIN lru_scan1(F); PH_END
                    PH_BEGIN lru_scan2(F, j); PH_END
                    PH_BEGIN GEMM_RES(MODL + 5 * D, 1.0f, ws + WS_MIX, ws + WS_WOUTC + (size_t)j * 2048 * 2560 * 2, 2560, 5); PH_END
                }
            }
            PH_BEGIN phase_norm(F, l, s == 0 ? 0 : 2, s == 0 ? (l == 0 ? 0 : 7) : ((l & 1) ? 5 : 4)); PH_END
            PH_BEGIN { EpiGU E{(bf16*)(ws + WS_HID)}; GEMM_CALL(EpiGU, pg8::StaticOrder, E, ws + WS_H, ws + WS_WGU + (size_t)(l * 2 + s) * 10752 * 2048 * 2, 2048, 2048, 2048, NPAN, 42); conv_slot(F, l, s == 0 ? 0 : 2, 106); } PH_END
            PH_BEGIN GEMM_RES(MODL + (s == 0 ? 2 : 8) * D, 0.5f, ws + WS_HID, ws + WS_WD + (size_t)(l * 2 + s) * 2048 * 5376 * 2, 5376, 7); PH_END
        }
    }
    PH_BEGIN phase_final(F, 7); PH_END
}
constexpr int N_PHASES = 2 + 4 * (3 + 1 + 3) + 2 * 6 + 2 * 6 + 1;

extern "C" void kernel_launch(void* const* d_in, const int* in_sizes, int n_in, void* d_out, int out_size, void* d_ws, size_t ws_size, hipStream_t stream) {
    static int grid = 0;
    if (grid == 0) {
        if (n_in != N_IN || (size_t)out_size != O_END || ws_size < WS_END) { fprintf(stderr, "kernel_launch: unexpected shapes: n_in %d out %d ws %zu (need %zu)\n", n_in, out_size, ws_size, (size_t)WS_END); grid = -1; return; }
        int dev = 0, cus = 0, per_cu = 0;
        if (hipGetDevice(&dev) != hipSuccess || hipDeviceGetAttribute(&cus, hipDeviceAttributeMultiprocessorCount, dev) != hipSuccess) { grid = -1; return; }
        if (hipFuncSetAttribute((const void*)fwd_kernel, hipFuncAttributeMaxDynamicSharedMemorySize, LDS_BYTES) != hipSuccess) { fprintf(stderr, "kernel_launch: hipFuncSetAttribute failed\n"); grid = -1; return; }
        if (hipOccupancyMaxActiveBlocksPerMultiprocessor(&per_cu, (const void*)fwd_kernel, NTHR, LDS_BYTES) != hipSuccess || per_cu < 1) { fprintf(stderr, "kernel_launch: occupancy query says %d\n", per_cu); }
        (void)hipGetLastError();
        grid = cus;
    }
    if (grid < 0) return;
    (void)hipMemsetAsync((char*)d_ws + WS_CTL, 0, CTL_BYTES, stream);
    Args a{};
    for (int i = 0; i < N_IN; ++i) a.in[i] = (const float*)d_in[i];
    a.out = (float*)d_out; a.ws = (unsigned char*)d_ws;
#ifndef MK_PER_PHASE
    a.lo = 0; a.hi = N_PHASES;
    hipLaunchKernelGGL(fwd_kernel, dim3(grid), dim3(NTHR), LDS_BYTES, stream, a);
#else
    for (int p = 0; p < N_PHASES; ++p) { a.lo = p; a.hi = p + 1; hipLaunchKernelGGL(fwd_kernel, dim3(grid), dim3(NTHR), LDS_BYTES, stream, a); }
#endif
}
```

```cpp
#include <hip/hip_runtime.h>
#include <cstdio>
#include <cstdint>

namespace pg8 {
#define PG8_LAS __attribute__((address_space(3)))
typedef unsigned short bf16_t;
typedef short bf16x8 __attribute__((ext_vector_type(8)));
typedef float f32x4 __attribute__((ext_vector_type(4)));
typedef unsigned u32x4 __attribute__((ext_vector_type(4)));
constexpr int BM = 256, BK = 64, HALF = 128, HTB = HALF * BK * 2  , STAGE_BYTES = 8 * HTB, NXCD = 8, WGM = 8;

__host__ __device__ __forceinline__ int lds_byte(int r, int c) { const int st = (r >> 4) * 2 + (c >> 5), rr = r & 15, cc = c & 31, ob = rr * 64 + cc * 2; return st * 1024 + (ob ^ (((ob >> 9) & 1) << 5)); }
__host__ __device__ __forceinline__ void stage_rc(int b, int& R, int& C) { const int st = b / 1024, sb = b % 1024, swz = sb ^ (((sb >> 9) & 1) << 5); R = (st >> 1) * 16 + swz / 64; C = (st & 1) * 32 + (swz % 64) / 2; }
__host__ __device__ __forceinline__ int perm32(int rho) { const int n = rho >> 4, i = rho & 15; return 8 * (i >> 2) + 4 * n + (i & 3); }

struct Unit { int pm, pn, ks; };
struct Gemm { const bf16_t* A; const bf16_t* Bt; int lda, ldb, K; };

struct StaticOrder {
    int nM, nN, nwg, G, c;
    __host__ __device__ void init(int nM_, int nN_, int G_, int c_) { nM = nM_; nN = nN_; nwg = nM * nN; G = G_; c = c_; }
    __host__ __device__ bool next(int i, Unit& u) const {
        const long L = (long)i * G + c; if (L >= nwg) return false;
        int wgid = (int)L; { const int q = nwg / NXCD, r = nwg % NXCD, xcd = wgid % NXCD, off = wgid / NXCD; wgid = (xcd < r ? xcd * (q + 1) : r * (q + 1) + (xcd - r) * q) + off; }
        const int nig = WGM * nN, gid = wgid / nig, fm = gid * WGM, gsz = (nM - fm) < WGM ? (nM - fm) : WGM;
        u.pm = fm + ((wgid % nig) % gsz); u.pn = (wgid % nig) / gsz; u.ks = 0; return true;
    }
    __device__ __forceinline__ int koff(const Unit&) const { return 0; }
    __device__ __forceinline__ int koffB(const Unit&) const { return 0; }
    __device__ __forceinline__ void a_ready(const Unit&) const {}
    __device__ __forceinline__ void done(const Unit&) const {}
};
struct GateOrder : StaticOrder {
    __device__ __forceinline__ int koff(const Unit& u) const { const int k0 = ((u.pn * 128) / 160) * 160; return k0 < 2176 ? k0 : 2176; }
    __device__ __forceinline__ int koffB(const Unit& u) const { return koff(u); }
};

struct SplitKOrder {
    int pm, nN, nwg, G, c, klen;
    __host__ __device__ void init(int pm_, int nN_, int nK_, int klen_, int G_, int c_) { pm = pm_; nN = nN_; nwg = nN_ * nK_; klen = klen_; G = G_; c = c_; }
    __host__ __device__ bool next(int i, Unit& u) const { const long L = (long)i * G + c; if (L >= nwg) return false; u.pm = pm; u.pn = (int)L % nN; u.ks = (int)L / nN; return true; }
    __device__ __forceinline__ int koff(const Unit& u) const { return u.ks * klen; }
    __device__ __forceinline__ int koffB(const Unit& u) const { return u.ks * klen; }
    __device__ __forceinline__ void a_ready(const Unit&) const {}
    __device__ __forceinline__ void done(const Unit&) const {}
};

__device__ __forceinline__ unsigned cvt_pk_bf16(float lo, float hi) { unsigned r; asm volatile("v_cvt_pk_bf16_f32 %0, %1, %2" : "=v"(r) : "v"(lo), "v"(hi)); return r; }

template <class Epi, class Sched, bool ALIGN_EPI = false, bool SP2 = false>
__device__ __forceinline__ void gemm_phase(PG8_LAS unsigned char* lds, const Gemm g, const Sched& S, const Epi& E, const int tid_in) {
    int tid_ = tid_in; asm volatile("" : "+v"(tid_));
    const int tid = tid_, wid = __builtin_amdgcn_readfirstlane(tid >> 6), lane = tid & 63, wr = wid >> 2, wc = wid & 3, fr = lane & 15, fq = lane >> 4;
    const int K = g.K, nt = K / BK;
    unsigned voffA[2], voffB[2];
#pragma unroll
    for (int i = 0; i < 2; ++i) { int R, C; stage_rc(tid * 16 + i * 8192, R, C); const int Rb = Epi::PERM ? ((R & ~31) + perm32(R & 31)) : R;
        voffA[i] = (unsigned)(R * g.lda + C) * 2u; voffB[i] = (unsigned)(Rb * g.ldb + C) * 2u; }
    const size_t kstep = (size_t)(BK * 2);
    const size_t hstepA = (size_t)HALF * g.lda * 2, hstepB = (size_t)HALF * g.ldb * 2;
    const size_t tstepA = 2 * hstepA, tstepB = 2 * hstepB;
    const unsigned ldsw = (unsigned)wid * 1024u;
    const int aoff = lds_byte(wr * 64 + fr, fq * 8), boff = lds_byte(wc * 32 + fr, fq * 8);
#define PG8_SA(b, h) (((b) * 2 + (h)) * HTB)
#define PG8_SB(b, h) ((4 + (b) * 2 + (h)) * HTB)
#define PG8_STAGE(bufoff, gbase, voff) do { _Pragma("unroll") for (int _i = 0; _i < 2; ++_i) \
        __builtin_amdgcn_global_load_lds((const unsigned*)((const char*)(gbase) + (voff)[_i]), (PG8_LAS unsigned*)(lds + (bufoff) + ldsw + _i * 8192), 16, 0, 0); } while (0)
#define PG8_LDA(dst, b, h) do { _Pragma("unroll") for (int m = 0; m < 4; ++m) _Pragma("unroll") for (int k = 0; k < 2; ++k) dst[m][k] = *(const PG8_LAS bf16x8*)(lds + PG8_SA(b, h) + aoff + m * 2048 + k * 1024); } while (0)
#define PG8_LDB(dst, b, h) do { _Pragma("unroll") for (int n = 0; n < 2; ++n) _Pragma("unroll") for (int k = 0; k < 2; ++k) dst[n][k] = *(const PG8_LAS bf16x8*)(lds + PG8_SB(b, h) + boff + n * 2048 + k * 1024); } while (0)
#define PG8_MMA(ai, bj, At, Bt) do { __builtin_amdgcn_s_setprio(1); _Pragma("unroll") for (int m = 0; m < 4; ++m) _Pragma("unroll") for (int n = 0; n < 2; ++n) _Pragma("unroll") for (int k = 0; k < 2; ++k) \
        acc[ai][bj][m][n] = __builtin_amdgcn_mfma_f32_16x16x32_bf16(Bt[n][k], At[m][k], acc[ai][bj][m][n], 0, 0, 0); __builtin_amdgcn_s_setprio(0); } while (0)
#define PG8_WAIT_V(n) asm volatile("s_waitcnt vmcnt(" #n ")" ::: "memory")
#define PG8_WAIT_L(n) asm volatile("s_waitcnt lgkmcnt(" #n ")" ::: "memory")
#define PG8_BAR __builtin_amdgcn_s_barrier()
#define PG8_SCHED __builtin_amdgcn_sched_barrier(0)
    Unit cur, nxt; int ui = 0;
    if (!S.next(0, cur)) return;
    f32x4 acc[2][2][4][2];
#pragma unroll
    for (int a = 0; a < 2; ++a)
#pragma unroll
        for (int b = 0; b < 2; ++b)
#pragma unroll
            for (int m = 0; m < 4; ++m)
#pragma unroll
                for (int n = 0; n < 2; ++n) acc[a][b][m][n] = (f32x4){0.f, 0.f, 0.f, 0.f};
    bf16x8 At[4][2], B0[2][2], B1[2][2];
    const char* cA = (const char*)g.A + (size_t)cur.pm * tstepA + (size_t)S.koff(cur) * 2; const char* cB = (const char*)g.Bt + (size_t)cur.pn * tstepB + (size_t)S.koffB(cur) * 2;
    S.a_ready(cur);
    if constexpr (SP2) {
        PG8_STAGE(PG8_SB(0, 0), cB, voffB); PG8_STAGE(PG8_SB(0, 1), cB + hstepB, voffB); PG8_STAGE(PG8_SA(0, 0), cA, voffA); PG8_STAGE(PG8_SA(0, 1), cA + hstepA, voffA);
        if (wr == 1) PG8_BAR;
        PG8_WAIT_V(2); PG8_BAR;
        PG8_STAGE(PG8_SB(1, 0), cB + kstep, voffB); PG8_STAGE(PG8_SA(1, 0), cA + kstep, voffA); PG8_STAGE(PG8_SB(1, 1), cB + hstepB + kstep, voffB);
        PG8_WAIT_V(6); PG8_BAR;
    } else {
        PG8_STAGE(PG8_SB(0, 0), cB, voffB); PG8_STAGE(PG8_SA(0, 0), cA, voffA); PG8_STAGE(PG8_SB(0, 1), cB + hstepB, voffB); PG8_STAGE(PG8_SA(0, 1), cA + hstepA, voffA);
        if (wr == 1) PG8_BAR;
        PG8_WAIT_V(4); PG8_BAR;
        PG8_STAGE(PG8_SB(1, 0), cB + kstep, voffB); PG8_STAGE(PG8_SA(1, 0), cA + kstep, voffA); PG8_STAGE(PG8_SB(1, 1), cB + hstepB + kstep, voffB);
        PG8_WAIT_V(6); PG8_BAR;
    }
    for (;;) {
        const bool has_next = S.next(ui + 1, nxt);
        const char* nA = has_next ? (const char*)g.A + (size_t)nxt.pm * tstepA + (size_t)S.koff(nxt) * 2 : cA; const char* nB = has_next ? (const char*)g.Bt + (size_t)nxt.pn * tstepB + (size_t)S.koffB(nxt) * 2 : cB;
#pragma unroll 1
        for (int t = 0; t < nt; t += 2) {
            const bool last = (t == nt - 2);
            const char* a1 = cA + (size_t)(t + 1) * kstep;
            const char* a2 = last ? nA : cA + (size_t)(t + 2) * kstep; const char* b2 = last ? nB : cB + (size_t)(t + 2) * kstep;
            const char* a3 = a2 + kstep; const char* b3 = b2 + kstep;
            if (last && has_next) S.a_ready(nxt);
            if constexpr (SP2) {
            PG8_LDB(B0, 0, 0); PG8_LDB(B1, 0, 1); PG8_SCHED; PG8_LDA(At, 0, 0); PG8_STAGE(PG8_SA(1, 1), a1 + hstepA, voffA);
            PG8_WAIT_V(8); PG8_WAIT_L(0); PG8_BAR; PG8_MMA(0, 0, At, B0); PG8_MMA(0, 1, At, B1); PG8_BAR; PG8_SCHED;
            PG8_LDA(At, 0, 1); PG8_STAGE(PG8_SB(0, 0), b2, voffB); PG8_STAGE(PG8_SB(0, 1), b2 + hstepB, voffB); PG8_STAGE(PG8_SA(0, 0), a2, voffA);
            PG8_WAIT_V(8); PG8_WAIT_L(0); PG8_BAR; PG8_MMA(1, 0, At, B0); PG8_MMA(1, 1, At, B1); PG8_BAR; PG8_SCHED;
            PG8_LDB(B0, 1, 0); PG8_LDB(B1, 1, 1); PG8_SCHED; PG8_LDA(At, 1, 0); PG8_STAGE(PG8_SA(0, 1), a2 + hstepA, voffA);
            PG8_WAIT_V(8); PG8_WAIT_L(0); PG8_BAR; PG8_MMA(0, 0, At, B0); PG8_MMA(0, 1, At, B1); PG8_BAR; PG8_SCHED;
            PG8_LDA(At, 1, 1); PG8_STAGE(PG8_SB(1, 0), b3, voffB); PG8_STAGE(PG8_SB(1, 1), b3 + hstepB, voffB); PG8_STAGE(PG8_SA(1, 0), a3, voffA);
            PG8_WAIT_V(8); PG8_WAIT_L(0); PG8_BAR; PG8_MMA(1, 0, At, B0); PG8_MMA(1, 1, At, B1); PG8_BAR; PG8_SCHED;
            } else {
            PG8_LDB(B0, 0, 0); PG8_SCHED; PG8_LDA(At, 0, 0); PG8_STAGE(PG8_SA(1, 1), a1 + hstepA, voffA);
            PG8_WAIT_L(8); PG8_BAR; PG8_WAIT_L(0); PG8_MMA(0, 0, At, B0); PG8_BAR; PG8_SCHED;
            PG8_LDB(B1, 0, 1); PG8_STAGE(PG8_SB(0, 0), b2, voffB);
            PG8_BAR; PG8_WAIT_L(0); PG8_MMA(0, 1, At, B1); PG8_BAR;
            PG8_LDA(At, 0, 1); PG8_STAGE(PG8_SA(0, 0), a2, voffA);
            PG8_BAR; PG8_WAIT_L(0); PG8_MMA(1, 0, At, B0); PG8_BAR; PG8_SCHED;
            PG8_STAGE(PG8_SB(0, 1), b2 + hstepB, voffB);
            PG8_WAIT_V(6); PG8_BAR; PG8_MMA(1, 1, At, B1); PG8_BAR;
            PG8_LDB(B0, 1, 0); PG8_SCHED; PG8_LDA(At, 1, 0); PG8_STAGE(PG8_SA(0, 1), a2 + hstepA, voffA);
            PG8_WAIT_L(8); PG8_BAR; PG8_WAIT_L(0); PG8_MMA(0, 0, At, B0); PG8_BAR; PG8_SCHED;
            PG8_LDB(B1, 1, 1); PG8_STAGE(PG8_SB(1, 0), b3, voffB);
            PG8_BAR; PG8_WAIT_L(0); PG8_MMA(0, 1, At, B1); PG8_BAR;
            PG8_LDA(At, 1, 1); PG8_STAGE(PG8_SA(1, 0), a3, voffA);
            PG8_BAR; PG8_WAIT_L(0); PG8_MMA(1, 0, At, B0); PG8_BAR; PG8_SCHED;
            PG8_STAGE(PG8_SB(1, 1), b3 + hstepB, voffB);
            PG8_WAIT_V(6); PG8_BAR; PG8_MMA(1, 1, At, B1); PG8_BAR;
            }
        }
        if constexpr (ALIGN_EPI) { if (wr == 0) PG8_BAR; }
        if constexpr (!Epi::AFTER_DRAIN) { E(acc, cur, wr, wc, fr, fq); S.done(cur); }
        if (!has_next) break;
#pragma unroll
        for (int a = 0; a < 2; ++a)
#pragma unroll
            for (int b = 0; b < 2; ++b)
#pragma unroll
                for (int m = 0; m < 4; ++m)
#pragma unroll
                    for (int n = 0; n < 2; ++n) acc[a][b][m][n] = (f32x4){0.f, 0.f, 0.f, 0.f};
        cur = nxt; cA = nA; cB = nB; ++ui;
        if constexpr (ALIGN_EPI) { if (wr == 1) PG8_BAR; }
    }
    PG8_WAIT_V(0);
    if constexpr (!ALIGN_EPI) { if (wr == 0) PG8_BAR; }
    PG8_BAR;
    if constexpr (Epi::AFTER_DRAIN) { E.fused(acc, cur, wr, wc, fr, fq, lds, wid, lane); S.done(cur); }
#undef PG8_SA
#undef PG8_SB
#undef PG8_STAGE
#undef PG8_LDA
#undef PG8_LDB
#undef PG8_MMA
#undef PG8_WAIT_V
#undef PG8_WAIT_L
#undef PG8_BAR
#undef PG8_SCHED
}
}

using pg8::f32x4; using pg8::u32x4; using pg8::Unit; using pg8::cvt_pk_bf16;
typedef unsigned short bf16;
typedef float f32x2 __attribute__((ext_vector_type(2)));
typedef unsigned u32x2 __attribute__((ext_vector_type(2)));
typedef _Float16 h16;
typedef _Float16 h16x8 __attribute__((ext_vector_type(8)));
typedef float f32x8 __attribute__((ext_vector_type(8)));
#define LAS __attribute__((address_space(3)))
constexpr int NWAVES = 8, NTHR = 512;
constexpr int D = 2048, TP = 8192, TS = 128, TT = 8320, MP = 8448, NPAN = 33;
constexpr int DFF = 5376, DIN = 5120, DRNN = 2560, DA = 1024;
constexpr int NMODW = 18432, MODLD = 73728;
constexpr float EPS = 1e-6f;
constexpr int LDS_BYTES = 147456;
constexpr int MISC_OFF = 131072 + 320;

constexpr size_t al256(size_t x) { return (x + 255) & ~(size_t)255; }
constexpr size_t WS_CTL = 0, CTL_BYTES = 1u << 20;
constexpr size_t WS_WGU = WS_CTL + CTL_BYTES;
constexpr size_t WS_WD = WS_WGU + (size_t)8 * 10752 * 2048 * 2;
constexpr size_t WS_WINAB = WS_WD + (size_t)8 * 2048 * 5376 * 2;
constexpr size_t WS_WGLU = WS_WINAB + (size_t)2 * 5120 * 2048 * 2;
constexpr size_t WS_WOUTAB = WS_WGLU + (size_t)2 * 1024 * 1024 * 2;
constexpr size_t WS_WINC = WS_WOUTAB + (size_t)2 * 2048 * 2048 * 2;
constexpr size_t WS_WOUTC = WS_WINC + (size_t)2 * 5120 * 2048 * 2;
constexpr size_t WS_WGATE = WS_WOUTC + (size_t)2 * 2048 * 2560 * 2;
constexpr size_t WS_WADA = WS_WGATE + (size_t)2 * 5120 * 2560 * 2;
constexpr size_t WS_SC = WS_WADA + (size_t)73728 * 2048 * 2;
constexpr size_t WS_MOD = WS_SC + (size_t)256 * 2048 * 2;
constexpr size_t WS_X = WS_MOD + (size_t)256 * 73728 * 4;
constexpr size_t WS_H = WS_X + (size_t)MP * D * 4;
constexpr size_t WS_HID = WS_H + (size_t)MP * D * 2;
constexpr size_t WS_Z = WS_HID + (size_t)MP * DFF * 2;
constexpr size_t WS_XR = WS_Z + (size_t)MP * DIN * 2;
constexpr size_t WS_XC = WS_XR + (size_t)MP * DRNN * 4;
constexpr size_t WS_XCB = WS_XC + (size_t)MP * DRNN * 4;
constexpr size_t WS_AA = WS_XCB + (size_t)MP * DRNN * 2;
constexpr size_t WS_BB = WS_AA + (size_t)MP * DRNN * 4;
constexpr size_t WS_MIX = WS_BB + (size_t)MP * DRNN * 4;
constexpr size_t WS_YA = WS_MIX + (size_t)MP * DRNN * 2;
constexpr size_t WS_OB = WS_YA + (size_t)MP * DA * 2;
constexpr size_t WS_S5E = WS_OB + (size_t)TP * 1024 * 4;
constexpr size_t WS_LRUP = WS_S5E + (size_t)4 * 64 * 8 * 128 * 4;
constexpr size_t WS_LB = WS_LRUP + (size_t)4 * 16 * 2560 * 2 * 4;
constexpr size_t WS_LL = WS_LB + 2 * 1024 * 4;
constexpr size_t WS_PART = WS_LL + 2 * 2560 * 4;
constexpr size_t WS_END = WS_PART + (size_t)21 * 128 * 2048 * 4;
constexpr size_t WS_HT = WS_XR, WS_HS = WS_XC, WS_QG = WS_AA, WS_HD = WS_BB;
constexpr int CW_BAR = 4096;

constexpr size_t O_Y = 0;
constexpr size_t O_PS5R = (size_t)TT * D;
constexpr size_t O_PS5I = O_PS5R + 2 * 4 * 64 * 64;
constexpr size_t O_PHG = O_PS5I + 2 * 4 * 64 * 64;
constexpr size_t O_PLRU = O_PHG + (size_t)2 * 4 * 8 * 128 * 128;
constexpr size_t O_PCONV = O_PLRU + 2 * 4 * 2560;
constexpr size_t O_SS5R = O_PCONV + 2 * 4 * 3 * 2560;
constexpr size_t O_SS5I = O_SS5R + (size_t)2 * 128 * 64 * 64;
constexpr size_t O_SHG = O_SS5I + (size_t)2 * 128 * 64 * 64;
constexpr size_t O_SLRU = O_SHG + (size_t)2 * 128 * 8 * 128 * 128;
constexpr size_t O_SCONV = O_SLRU + (size_t)2 * 128 * 2560;
constexpr size_t O_END = O_SCONV + (size_t)2 * 128 * 3 * 2560;

enum { I_XP = 0, I_XS, I_S5RE, I_S5IM, I_HG, I_LRU, I_CONV, I_CP, I_CS, I_NW, I_FNW, I_WADA, I_BADA, I_WGU, I_WD, I_WINAB, I_LAMRE, I_LAMIM, I_BRE, I_BIM, I_CRE, I_CIM, I_S5D, I_LSTEP,
       I_WGLU, I_BGLU, I_LBL, I_HGNW, I_WOUTAB, I_WINC, I_CONVW, I_CONVB, I_WGA, I_BGA, I_WGX, I_BGX, I_LAMBDA, I_WOUTC, N_IN };

__device__ __forceinline__ float bflo(unsigned w) { return __uint_as_float(w << 16); }
__device__ __forceinline__ float bfhi(unsigned w) { return __uint_as_float(w & 0xffff0000u); }
__device__ __forceinline__ float fsigmoid(float x) { return __builtin_amdgcn_rcpf(1.0f + __expf(-x)); }
__device__ __forceinline__ float fsilu(float x) { return x * fsigmoid(x); }
__device__ __forceinline__ float fgelu(float x) { const float u = 0.7978845608f * (x + 0.044715f * x * x * x); return x * fsigmoid(2.0f * u); }
__device__ __forceinline__ int mrow_of(int row) { return row < TP ? (row >> 11) : ((row - TP + 4) < 131 ? (row - TP + 4) : 131); }
#define DPP_F(p, ctrl) __int_as_float(__builtin_amdgcn_update_dpp(0, __float_as_int(p), (ctrl), 0xF, 0xF, true))
__device__ __forceinline__ float row16_sum(float p) { p += DPP_F(p, 0xB1); p += DPP_F(p, 0x4E); p += DPP_F(p, 0x141); p += DPP_F(p, 0x140); return p; }
__device__ __forceinline__ float wave_sum(float v) {
    v = row16_sum(v); const int b = __float_as_int(v);
    return (__int_as_float(__builtin_amdgcn_readlane(b, 0)) + __int_as_float(__builtin_amdgcn_readlane(b, 16))) + (__int_as_float(__builtin_amdgcn_readlane(b, 32)) + __int_as_float(__builtin_amdgcn_readlane(b, 48)));
}
__device__ __forceinline__ float swz_xor16(float v) { return __int_as_float(__builtin_amdgcn_ds_swizzle(__float_as_int(v), 0x401F)); }
__device__ __forceinline__ float oct_sum(float p) { p += DPP_F(p, 0xB1); p += DPP_F(p, 0x4E); p += DPP_F(p, 0x141); return p; }
__device__ __forceinline__ void sincos_acc(float x, float& s, float& c) {
    const float k = rintf(x * 0.636619772f);
    float y = fmaf(k, -1.5703125f, x); y = fmaf(k, -4.837512969970703125e-4f, y); y = fmaf(k, -7.54978995489188216e-8f, y);
    const float y2 = y * y;
    float sp = fmaf(y2, 2.7557319e-6f, -1.9841270e-4f); sp = fmaf(sp, y2, 8.3333333e-3f); sp = fmaf(sp, y2, -1.6666667e-1f); sp = fmaf(sp * y2, y, y);
    float cp = fmaf(y2, -2.7557319e-7f, 2.4801587e-5f); cp = fmaf(cp, y2, -1.3888889e-3f); cp = fmaf(cp, y2, 4.1666667e-2f); cp = fmaf(cp, y2, -0.5f); cp = fmaf(cp, y2, 1.0f);
    const int q = ((int)k) & 3;
    s = (q == 0) ? sp : (q == 1) ? cp : (q == 2) ? -sp : -cp;
    c = (q == 0) ? cp : (q == 1) ? -sp : (q == 2) ? -cp : sp;
}

#define XB_TMO      128
#define XB_XCNT(j)  (256  + 64 * (j))
#define XB_XSUB(j)  (1280 + 64 * (j))
#define XB_XGEN(j)  (2304 + 64 * (j))
#define XB_TOP      3328
#define XB_TOPGEN   3392
#define XCD_BAR_WORDS 3456
#define XB_SPIN_CAP (1u << 18)
__device__ __forceinline__ unsigned xb_ld(unsigned* p)              { return __hip_atomic_load(p, __ATOMIC_RELAXED, __HIP_MEMORY_SCOPE_AGENT); }
__device__ __forceinline__ unsigned xb_add(unsigned* p, unsigned v) { return __hip_atomic_fetch_add(p, v, __ATOMIC_RELAXED, __HIP_MEMORY_SCOPE_AGENT); }
__device__ __forceinline__ unsigned xb_xcc_id() { return (unsigned)__builtin_amdgcn_s_getreg((3 << 11) | 20) & 0xFu; }
#define XB_SPIN(cond, bar) do { unsigned _sp = 0; while (cond) { __builtin_amdgcn_s_sleep(1); \
    if ((++_sp & 255u) == 0u) { if (xb_ld(&(bar)[XB_TMO])) break; if (_sp > XB_SPIN_CAP) { atomicAdd(&(bar)[XB_TMO], 1u); break; } } } } while (0)
struct XcdBarrier { unsigned* bar; unsigned x; volatile LAS unsigned* st; int wid; };
__device__ __forceinline__ bool xb_leader(int wid) { return wid == 0 && __builtin_amdgcn_mbcnt_hi(~0u, __builtin_amdgcn_mbcnt_lo(~0u, 0u)) == 0u; }
__device__ __forceinline__ XcdBarrier xcd_barrier_post(unsigned* bar, volatile LAS unsigned* st, int wid) {
    XcdBarrier b; b.bar = bar; b.x = xb_xcc_id(); b.st = st; b.wid = wid;
    if (xb_leader(wid)) (void)xb_add(&bar[XB_XCNT(b.x)], 1u);
    return b;
}
__device__ __forceinline__ void xcd_barrier_complete(unsigned* bar, unsigned x, unsigned& nloc, unsigned& nx) {
    const unsigned G = gridDim.x * gridDim.y * gridDim.z;
    unsigned sum, cnt, mine, sp = 0u;
    for (;;) {
        sum = 0u; cnt = 0u; mine = 0u;
#pragma unroll
        for (unsigned j = 0; j < 16; ++j) { const unsigned c = xb_ld(&bar[XB_XCNT(j)]); sum += c; cnt += (c > 0u) ? 1u : 0u; mine = (j == x) ? c : mine; }
        if (sum == G) break;
        __builtin_amdgcn_s_sleep(1);
        if ((++sp & 255u) == 0u) { if (xb_ld(&bar[XB_TMO])) break; if (sp > XB_SPIN_CAP) { atomicAdd(&bar[XB_TMO], 1u); break; } }
    }
    nloc = mine > 0u ? mine : 1u; nx = cnt > 0u ? cnt : 1u;
}
__device__ __forceinline__ void xcd_barrier(const XcdBarrier& b) {
    asm volatile("s_waitcnt vmcnt(0)" ::: "memory");
    __syncthreads();
    if (xb_leader(b.wid)) {
        unsigned* bar = b.bar;
        __builtin_amdgcn_s_waitcnt(0);
        unsigned nloc = b.st[0], nx = b.st[1];
        if (nloc == 0u) { xcd_barrier_complete(bar, b.x, nloc, nx); b.st[0] = nloc; b.st[1] = nx; }
        const unsigned old = xb_add(&bar[XB_XSUB(b.x)], 1u);
        const unsigned gen = old / nloc;
        if (old + 1u == (gen + 1u) * nloc) {
            __builtin_amdgcn_fence(__ATOMIC_RELEASE, "agent");
            asm volatile("s_waitcnt vmcnt(0)" ::: "memory");
            const unsigned og = xb_add(&bar[XB_TOP], 1u);
            const unsigned tg = og / nx;
            if (og + 1u == (tg + 1u) * nx) xb_add(&bar[XB_TOPGEN], 1u);
            else XB_SPIN(xb_ld(&bar[XB_TOPGEN]) == tg, bar);
            __builtin_amdgcn_fence(__ATOMIC_ACQUIRE, "agent");
            xb_add(&bar[XB_XGEN(b.x)], 1u);
            asm volatile("s_waitcnt vmcnt(0)" ::: "memory");
        } else {
            XB_SPIN(xb_ld(&bar[XB_XGEN(b.x)]) == gen, bar);
            __builtin_amdgcn_fence(__ATOMIC_ACQUIRE, "agent");
            asm volatile("s_waitcnt vmcnt(0)" ::: "memory");
        }
    }
    __syncthreads();
}

struct EpiF32B {
    static constexpr bool PERM = false, AFTER_DRAIN = false;
    float* C; int ldc; const float* bias;
    __device__ __forceinline__ void operator()(const f32x4 (&acc)[2][2][4][2], const Unit& u, int wr, int wc, int fr, int fq) const {
        const int row0 = u.pm * 256 + wr * 64 + fr, col0 = u.pn * 256 + wc * 32 + 4 * fq;
        f32x4 bv[2][2];
#pragma unroll
        for (int bj = 0; bj < 2; ++bj)
#pragma unroll
            for (int n = 0; n < 2; ++n) bv[bj][n] = *(const f32x4*)(bias + col0 + bj * 128 + n * 16);
#pragma unroll
        for (int ai = 0; ai < 2; ++ai)
#pragma unroll
            for (int m = 0; m < 4; ++m) { float* rowp = C + (size_t)(row0 + ai * 128 + m * 16) * ldc + col0;
#pragma unroll
                for (int bj = 0; bj < 2; ++bj)
#pragma unroll
                    for (int n = 0; n < 2; ++n) *(f32x4*)(rowp + bj * 128 + n * 16) = acc[ai][bj][m][n] + bv[bj][n]; }
    }
};
struct EpiBf16 {
    static constexpr bool PERM = true, AFTER_DRAIN = false;
    bf16* O; int ldc;
    __device__ __forceinline__ void operator()(const f32x4 (&acc)[2][2][4][2], const Unit& u, int wr, int wc, int fr, int fq) const {
        const int row0 = u.pm * 256 + wr * 64 + fr, col0 = u.pn * 256 + wc * 32 + 8 * fq;
#pragma unroll
        for (int ai = 0; ai < 2; ++ai)
#pragma unroll
            for (int m = 0; m < 4; ++m) { bf16* rowp = O + (size_t)(row0 + ai * 128 + m * 16) * ldc + col0;
#pragma unroll
                for (int bj = 0; bj < 2; ++bj) { const f32x4 v0 = acc[ai][bj][m][0], v1 = acc[ai][bj][m][1];
                    u32x4 w; w.x = cvt_pk_bf16(v0[0], v0[1]); w.y = cvt_pk_bf16(v0[2], v0[3]); w.z = cvt_pk_bf16(v1[0], v1[1]); w.w = cvt_pk_bf16(v1[2], v1[3]);
                    *(u32x4*)(rowp + bj * 128) = w; } }
    }
};
struct EpiGU {
    static constexpr bool PERM = true, AFTER_DRAIN = false;
    bf16* O;
    __device__ __forceinline__ void operator()(const f32x4 (&acc)[2][2][4][2], const Unit& u, int wr, int wc, int fr, int fq) const {
        const int row0 = u.pm * 256 + wr * 64 + fr, col0 = u.pn * 128 + wc * 32 + 8 * fq;
#pragma unroll
        for (int ai = 0; ai < 2; ++ai)
#pragma unroll
            for (int m = 0; m < 4; ++m) { bf16* rowp = O + (size_t)(row0 + ai * 128 + m * 16) * DFF + col0;
                float h[8];
#pragma unroll
                for (int n = 0; n < 2; ++n)
#pragma unroll
                    for (int i = 0; i < 4; ++i) h[4 * n + i] = fsilu(acc[ai][0][m][n][i]) * acc[ai][1][m][n][i];
                u32x4 w; w.x = cvt_pk_bf16(h[0], h[1]); w.y = cvt_pk_bf16(h[2], h[3]); w.z = cvt_pk_bf16(h[4], h[5]); w.w = cvt_pk_bf16(h[6], h[7]);
                *(u32x4*)rowp = w; }
    }
};
struct EpiRes {
    static constexpr bool PERM = true, AFTER_DRAIN = false;
    h16* X; const float* mod; float scale;
    __device__ __forceinline__ void operator()(const f32x4 (&acc)[2][2][4][2], const Unit& u, int wr, int wc, int fr, int fq) const {
        const int row0 = u.pm * 256 + wr * 64 + fr, col0 = u.pn * 256 + wc * 32 + 8 * fq;
        h16* xb = X + (size_t)row0 * D + col0; const float* mp = mod + (size_t)(row0 >> 11) * MODLD + col0;
        f32x4 g[2][2];
#pragma unroll
        for (int bj = 0; bj < 2; ++bj)
#pragma unroll
            for (int n = 0; n < 2; ++n) g[bj][n] = *(const f32x4*)(mp + bj * 128 + 4 * n) * scale;
#pragma unroll
        for (int ai = 0; ai < 2; ++ai) { h16x8 xv[4][2];
#pragma unroll
            for (int m = 0; m < 4; ++m)
#pragma unroll
                for (int bj = 0; bj < 2; ++bj) xv[m][bj] = *(const h16x8*)(xb + (size_t)(ai * 128 + m * 16) * D + bj * 128);
#pragma unroll
            for (int m = 0; m < 4; ++m)
#pragma unroll
                for (int bj = 0; bj < 2; ++bj) { const f32x8 xf = __builtin_convertvector(xv[m][bj], f32x8); const f32x4 v0 = g[bj][0] * acc[ai][bj][m][0], v1 = g[bj][1] * acc[ai][bj][m][1];
                    const f32x8 o = xf + (f32x8){v0[0], v0[1], v0[2], v0[3], v1[0], v1[1], v1[2], v1[3]}; *(h16x8*)(xb + (size_t)(ai * 128 + m * 16) * D + bj * 128) = __builtin_convertvector(o, h16x8); }
            asm volatile("" ::: "memory"); }
    }
};
struct EpiResPart {
    static constexpr bool PERM = false, AFTER_DRAIN = false;
    float* P; const float* mod; float scale;
    __device__ __forceinline__ void operator()(const f32x4 (&acc)[2][2][4][2], const Unit& u, int wr, int wc, int fr, int fq) const {
        const int row0 = u.pm * 256 + wr * 64 + fr, col0 = u.pn * 256 + wc * 32 + 4 * fq;
#pragma unroll
        for (int m = 0; m < 4; ++m) { const int row = row0 + m * 16;
            if (row < TT) { float* pp = P + ((size_t)u.ks * 128 + (row - TP)) * D + col0; const float* mp = mod + (size_t)mrow_of(row) * MODLD + col0;
#pragma unroll
                for (int bj = 0; bj < 2; ++bj)
#pragma unroll
                    for (int n = 0; n < 2; ++n) { const f32x4 g = *(const f32x4*)(mp + bj * 128 + n * 16); *(f32x4*)(pp + bj * 128 + n * 16) = (g * scale) * acc[0][bj][m][n]; } }
            asm volatile("" ::: "memory"); }
    }
};
struct EpiInC {
    static constexpr bool PERM = true, AFTER_DRAIN = false;
    bf16* GB; bf16* XR;
    __device__ __forceinline__ void operator()(const f32x4 (&acc)[2][2][4][2], const Unit& u, int wr, int wc, int fr, int fq) const {
        const int row0 = u.pm * 256 + wr * 64 + fr; const bool gate = u.pn < 10; bf16* base = gate ? GB : XR; const int col0 = (gate ? u.pn : u.pn - 10) * 256 + wc * 32 + 8 * fq;
#pragma unroll
        for (int ai = 0; ai < 2; ++ai)
#pragma unroll
            for (int m = 0; m < 4; ++m) { bf16* rowp = base + (size_t)(row0 + ai * 128 + m * 16) * DRNN + col0;
#pragma unroll
                for (int bj = 0; bj < 2; ++bj) { f32x4 v0 = acc[ai][bj][m][0], v1 = acc[ai][bj][m][1];
                    if (gate) {
#pragma unroll
                        for (int i = 0; i < 4; ++i) { v0[i] = fgelu(v0[i]); v1[i] = fgelu(v1[i]); } }
                    u32x4 w; w.x = cvt_pk_bf16(v0[0], v0[1]); w.y = cvt_pk_bf16(v0[2], v0[3]); w.z = cvt_pk_bf16(v1[0], v1[1]); w.w = cvt_pk_bf16(v1[2], v1[3]);
                    *(u32x4*)(rowp + bj * 128) = w; } }
    }
};
struct EpiGlu {
    static constexpr bool PERM = true, AFTER_DRAIN = false;
    bf16* O; const bf16* YA; const float* bias;
    __device__ __forceinline__ void operator()(const f32x4 (&acc)[2][2][4][2], const Unit& u, int wr, int wc, int fr, int fq) const {
        const int row0 = u.pm * 256 + wr * 64 + fr, col0 = u.pn * 256 + wc * 32 + 8 * fq;
        f32x4 bv[2][2];
#pragma unroll
        for (int bj = 0; bj < 2; ++bj)
#pragma unroll
            for (int n = 0; n < 2; ++n) bv[bj][n] = *(const f32x4*)(bias + col0 + bj * 128 + 4 * n);
#pragma unroll
        for (int ai = 0; ai < 2; ++ai)
#pragma unroll
            for (int m = 0; m < 4; ++m) { const size_t row = (size_t)(row0 + ai * 128 + m * 16);
#pragma unroll
                for (int bj = 0; bj < 2; ++bj) { const u32x4 yv = *(const u32x4*)(YA + row * DA + col0 + bj * 128);
                    const f32x4 v0 = acc[ai][bj][m][0] + bv[bj][0], v1 = acc[ai][bj][m][1] + bv[bj][1];
                    u32x4 w; w.x = cvt_pk_bf16(bflo(yv.x) * fsigmoid(v0[0]), bfhi(yv.x) * fsigmoid(v0[1])); w.y = cvt_pk_bf16(bflo(yv.y) * fsigmoid(v0[2]), bfhi(yv.y) * fsigmoid(v0[3]));
                    w.z = cvt_pk_bf16(bflo(yv.z) * fsigmoid(v1[0]), bfhi(yv.z) * fsigmoid(v1[1])); w.w = cvt_pk_bf16(bflo(yv.w) * fsigmoid(v1[2]), bfhi(yv.w) * fsigmoid(v1[3]));
                    *(u32x4*)(O + row * D + col0 + bj * 128) = w; }
                asm volatile("" ::: "memory"); }
    }
};
__device__ __forceinline__ float em1_neg(float x) { float p = fmaf(x, 1.0f / 720.0f, 1.0f / 120.0f); p = fmaf(p, x, 1.0f / 24.0f); p = fmaf(p, x, 1.0f / 6.0f); p = fmaf(p, x, 0.5f); p = fmaf(p, x, 1.0f); p *= x;
    return x > -0.25f ? p : __expf(x) - 1.0f; }
struct EpiGate {
    static constexpr bool PERM = false, AFTER_DRAIN = false;
    unsigned* AB; const bf16* XC; const float* bga; const float* bgx; const float* ll;
    __device__ __forceinline__ void operator()(const f32x4 (&acc)[2][2][4][2], const Unit& u, int wr, int wc, int fr, int fq) const {
        const int row0 = u.pm * 256 + wr * 64 + fr, ch0 = u.pn * 128 + wc * 32 + 4 * fq;
#pragma unroll
        for (int n = 0; n < 2; ++n) { const f32x4 ba = *(const f32x4*)(bga + ch0 + 16 * n), bx = *(const f32x4*)(bgx + ch0 + 16 * n), lv = *(const f32x4*)(ll + ch0 + 16 * n);
#pragma unroll
            for (int ai = 0; ai < 2; ++ai)
#pragma unroll
                for (int m = 0; m < 4; ++m) { const int row = row0 + ai * 128 + m * 16;
                    if (row < TT) { const size_t off = (size_t)row * DRNN + ch0 + 16 * n; const u32x2 xw = *(const u32x2*)(XC + off); const f32x4 xc = (f32x4){bflo(xw.x), bfhi(xw.x), bflo(xw.y), bfhi(xw.y)}; u32x4 o;
#pragma unroll
                        for (int i = 0; i < 4; ++i) { const float r = fsigmoid(acc[ai][0][m][n][i] + ba[i]), ig = fsigmoid(acc[ai][1][m][n][i] + bx[i]);
                            const float la = r * lv[i]; o[i] = cvt_pk_bf16(la, sqrtf(fmaxf(-em1_neg(2.0f * la), 0.0f)) * ig * xc[i]); }
                        *(u32x4*)(AB + off) = o; }
                    asm volatile("" ::: "memory"); } }
    }
};


struct Args { const float* in[N_IN]; float* out; unsigned char* ws; int lo, hi; };
typedef const __attribute__((address_space(4))) unsigned long long* kargp_t;
__device__ __forceinline__ kargp_t kargs() { kargp_t p = (kargp_t)__builtin_amdgcn_kernarg_segment_ptr(); asm volatile("" : "+s"(p)); return p; }
#define INP(i) ((const float*)kargs()[(i)])
#define OUTP ((float*)kargs()[N_IN])
#define WSP ((unsigned char*)kargs()[N_IN + 1])
struct Frame { LAS unsigned char* lds; int tid, lane, wave, vcu, G, gw, NGW, gt, NT, bx; };

__device__ __forceinline__ void tr_item(const float* W, int ldw, int k0, int n0, bf16* WT, int ldk, int drow0, int lane) {
    const int n4 = (lane & 15) * 4, kg = lane >> 4; f32x4 v[2][8];
#pragma unroll
    for (int kh = 0; kh < 2; ++kh) { const float* src = W + (size_t)(k0 + kh * 32 + kg * 8) * ldw + n0 + n4;
#pragma unroll
        for (int i = 0; i < 8; ++i) v[kh][i] = __builtin_nontemporal_load((const f32x4*)(src + (size_t)i * ldw)); }
#pragma unroll
    for (int kh = 0; kh < 2; ++kh)
#pragma unroll
        for (int e = 0; e < 4; ++e) { u32x4 o; o.x = cvt_pk_bf16(v[kh][0][e], v[kh][1][e]); o.y = cvt_pk_bf16(v[kh][2][e], v[kh][3][e]); o.z = cvt_pk_bf16(v[kh][4][e], v[kh][5][e]); o.w = cvt_pk_bf16(v[kh][6][e], v[kh][7][e]);
            *(u32x4*)(WT + (size_t)(drow0 + n4 + e) * ldk + k0 + kh * 32 + kg * 8) = o; }
}
constexpr int IT_GU = 32 * 168, IT_D = 84 * 32, IT_INAB = 32 * 80, IT_GLU = 16 * 16, IT_OUTAB = 32 * 32, IT_INC = 32 * 80, IT_OUTC = 40 * 32;
constexpr int NITEMS_CONV = 8 * IT_GU + 8 * IT_D + 2 * IT_INAB + 2 * IT_GLU + 2 * IT_OUTAB + 2 * IT_INC + 2 * IT_OUTC;

__device__ __forceinline__ void conv_item(int it, int lane) {
    unsigned char* ws = WSP; int r = it;
    if (r < 8 * IT_GU) { const int idx = r / IT_GU; r -= idx * IT_GU; const int kb = r / 168, nb = r % 168, n0 = 64 * nb;
        const int drow = n0 < DFF ? (n0 >> 7) * 256 + (n0 & 127) : ((n0 - DFF) >> 7) * 256 + 128 + ((n0 - DFF) & 127);
        tr_item(INP(I_WGU) + (size_t)idx * 2048 * 10752, 10752, 64 * kb, n0, (bf16*)(ws + WS_WGU) + (size_t)idx * 10752 * 2048, 2048, drow, lane); return; }
    r -= 8 * IT_GU;
    if (r < 8 * IT_D) { const int idx = r / IT_D; r -= idx * IT_D; const int kb = r / 32, nb = r % 32;
        tr_item(INP(I_WD) + (size_t)idx * 5376 * 2048, 2048, 64 * kb, 64 * nb, (bf16*)(ws + WS_WD) + (size_t)idx * 2048 * 5376, 5376, 64 * nb, lane); return; }
    r -= 8 * IT_D;
    if (r < 2 * IT_INAB) { const int idx = r / IT_INAB; r -= idx * IT_INAB; const int kb = r / 80, nb = r % 80;
        tr_item(INP(I_WINAB) + (size_t)idx * 2048 * 5120, 5120, 64 * kb, 64 * nb, (bf16*)(ws + WS_WINAB) + (size_t)idx * 5120 * 2048, 2048, 64 * nb, lane); return; }
    r -= 2 * IT_INAB;
    if (r < 2 * IT_GLU) { const int idx = r / IT_GLU; r -= idx * IT_GLU; const int kb = r / 16, nb = r % 16;
        tr_item(INP(I_WGLU) + (size_t)idx * 1024 * 1024, 1024, 64 * kb, 64 * nb, (bf16*)(ws + WS_WGLU) + (size_t)idx * 1024 * 1024, 1024, 64 * nb, lane); return; }
    r -= 2 * IT_GLU;
    if (r < 2 * IT_OUTAB) { const int idx = r / IT_OUTAB; r -= idx * IT_OUTAB; const int kb = r / 32, nb = r % 32;
        tr_item(INP(I_WOUTAB) + (size_t)idx * 2048 * 2048, 2048, 64 * kb, 64 * nb, (bf16*)(ws + WS_WOUTAB) + (size_t)idx * 2048 * 2048, 2048, 64 * nb, lane); return; }
    r -= 2 * IT_OUTAB;
    if (r < 2 * IT_INC) { const int idx = r / IT_INC; r -= idx * IT_INC; const int kb = r / 80, nb = r % 80;
        tr_item(INP(I_WINC) + (size_t)idx * 2048 * 5120, 5120, 64 * kb, 64 * nb, (bf16*)(ws + WS_WINC) + (size_t)idx * 5120 * 2048, 2048, 64 * nb, lane); return; }
    r -= 2 * IT_INC;
    { const int idx = r / IT_OUTC; r -= idx * IT_OUTC; const int kb = r / 32, nb = r % 32;
      tr_item(INP(I_WOUTC) + (size_t)idx * 2560 * 2048, 2048, 64 * kb, 64 * nb, (bf16*)(ws + WS_WOUTC) + (size_t)idx * 2048 * 2560, 2560, 64 * nb, lane); }
}

constexpr int IT_LAYER = 2 * IT_GU + 2 * IT_D + IT_INAB + IT_GLU + IT_OUTAB;
static_assert(IT_LAYER == 2 * IT_GU + 2 * IT_D + IT_INC + IT_OUTC && 4 * IT_LAYER == NITEMS_CONV, "per-layer conversion item counts");
__device__ __forceinline__ void conv_ordered(int oi, int lane) {
    const int l = oi / IT_LAYER, j = l >> 1; int r = oi - l * IT_LAYER; int kind_base;
    const int B_D = 8 * IT_GU, B_INAB = B_D + 8 * IT_D, B_GLU = B_INAB + 2 * IT_INAB, B_OUTAB = B_GLU + 2 * IT_GLU, B_INC = B_OUTAB + 2 * IT_OUTAB, B_OUTC = B_INC + 2 * IT_INC;
    if (r < IT_GU) kind_base = (2 * l) * IT_GU;
    else if ((r -= IT_GU) < IT_D) kind_base = B_D + (2 * l) * IT_D;
    else { r -= IT_D;
        if ((l & 1) == 0) {
            if (r < IT_INAB) kind_base = B_INAB + j * IT_INAB;
            else if ((r -= IT_INAB) < IT_GLU) kind_base = B_GLU + j * IT_GLU;
            else if ((r -= IT_GLU) < IT_OUTAB) kind_base = B_OUTAB + j * IT_OUTAB;
            else { r -= IT_OUTAB; if (r < IT_GU) kind_base = (2 * l + 1) * IT_GU; else { r -= IT_GU; kind_base = B_D + (2 * l + 1) * IT_D; } }
        } else {
            if (r < IT_INC) kind_base = B_INC + j * IT_INC;
            else if ((r -= IT_INC) < IT_OUTC) kind_base = B_OUTC + j * IT_OUTC;
            else { r -= IT_OUTC; if (r < IT_GU) kind_base = (2 * l + 1) * IT_GU; else { r -= IT_GU; kind_base = B_D + (2 * l + 1) * IT_D; } }
        }
    }
    conv_item(kind_base + r, lane);
}
constexpr int CONV_IPW = 5;
constexpr int SLOT_GU = (256 - 106) * 8 * CONV_IPW, SLOT_IN = (256 - 148) * 8 * CONV_IPW;
constexpr int SLOT_LAYER = 2 * SLOT_GU + SLOT_IN;
constexpr int CONV_PRO = 4 * IT_LAYER - 3 * SLOT_LAYER > IT_LAYER ? 4 * IT_LAYER - 3 * SLOT_LAYER : IT_LAYER;
static_assert(CONV_PRO >= IT_LAYER && CONV_PRO + SLOT_LAYER >= 2 * IT_LAYER && CONV_PRO + 2 * SLOT_LAYER >= 3 * IT_LAYER && CONV_PRO + 3 * SLOT_LAYER >= 4 * IT_LAYER, "every layer's weights are converted before the layer starts");
__device__ __forceinline__ void conv_slot(const Frame& F, int l, int slot, int first_idle) {
    if (l >= 3 || F.bx < first_idle) return;
    const int start = CONV_PRO + l * SLOT_LAYER + (slot == 0 ? 0 : slot == 1 ? SLOT_GU : SLOT_GU + SLOT_IN), n = (slot == 1 ? SLOT_IN : SLOT_GU), nw = (256 - first_idle) * 8, w = (F.bx - first_idle) * 8 + F.wave;
    for (int q = 0; q < CONV_IPW; ++q) { const int it = start + q * nw + w; if (q * nw + w < n && it < NITEMS_CONV) conv_ordered(it, F.lane); }
}

__device__ __forceinline__ void phase_ada(const Frame& F, int item0, int istride) {
    unsigned char* ws = WSP; const bf16* SC = (const bf16*)(ws + WS_SC); float* MOD = (float*)(ws + WS_MOD);
    const int r = F.lane & 15, kq = F.lane >> 4;
    for (int item = item0; item < 1152; item += istride) { const int l = item / 288, n0 = (item % 288) * 64;
        const float* W = INP(I_WADA) + (size_t)l * 2048 * NMODW + (size_t)(kq * 8) * NMODW + n0 + 4 * r; const bf16* sp = SC + (size_t)r * D + kq * 8;
        f32x4 acc[9][4];
#pragma unroll
        for (int bt = 0; bt < 9; ++bt)
#pragma unroll
            for (int e = 0; e < 4; ++e) acc[bt][e] = (f32x4){0.f, 0.f, 0.f, 0.f};
#pragma unroll 2
        for (int ks = 0; ks < 64; ++ks) { f32x4 w[8];
#pragma unroll
            for (int i = 0; i < 8; ++i) w[i] = __builtin_nontemporal_load((const f32x4*)(W + (size_t)(ks * 32 + i) * NMODW));
            pg8::bf16x8 wb[4];
#pragma unroll
            for (int e = 0; e < 4; ++e) { u32x4 o; o.x = cvt_pk_bf16(w[0][e], w[1][e]); o.y = cvt_pk_bf16(w[2][e], w[3][e]); o.z = cvt_pk_bf16(w[4][e], w[5][e]); o.w = cvt_pk_bf16(w[6][e], w[7][e]); wb[e] = __builtin_bit_cast(pg8::bf16x8, o); }
#pragma unroll
            for (int bt = 0; bt < 9; ++bt) { const pg8::bf16x8 sa = *(const pg8::bf16x8*)(sp + (size_t)(bt * 16) * D + ks * 32);
#pragma unroll
                for (int e = 0; e < 4; ++e) acc[bt][e] = __builtin_amdgcn_mfma_f32_16x16x32_bf16(wb[e], sa, acc[bt][e], 0, 0, 0); }
        }
        const float* bias = INP(I_BADA) + (size_t)l * NMODW + n0 + 16 * kq; f32x4 bv[4];
#pragma unroll
        for (int t = 0; t < 4; ++t) bv[t] = *(const f32x4*)(bias + 4 * t);
#pragma unroll
        for (int bt = 0; bt < 9; ++bt) { const int brow = bt * 16 + r;
            if (brow < 132) { float* op = MOD + (size_t)brow * MODLD + (size_t)l * NMODW + n0 + 16 * kq;
#pragma unroll
                for (int t = 0; t < 4; ++t) *(f32x4*)(op + 4 * t) = (f32x4){acc[bt][0][t], acc[bt][1][t], acc[bt][2][t], acc[bt][3][t]} + bv[t]; } }
    }
}

__device__ __forceinline__ void phase_prologue(const Frame& F) {
    unsigned char* ws = WSP;
    { h16x8* X8 = (h16x8*)(ws + WS_X); const f32x8* xp = (const f32x8*)INP(I_XP); const f32x8* xs = (const f32x8*)INP(I_XS);
      for (int i = F.gt; i < MP * 256; i += F.NT) { const int row = i >> 8; f32x8 v = (f32x8){0.f, 0.f, 0.f, 0.f, 0.f, 0.f, 0.f, 0.f};
          if (row < TP) v = xp[i]; else if (row < TT) v = xs[i - TP * 256]; X8[i] = __builtin_convertvector(v, h16x8); } }
    { u32x4* Hp = (u32x4*)(ws + WS_H + (size_t)TT * D * 2); for (int i = F.gt; i < (MP - TT) * D / 8; i += F.NT) Hp[i] = (u32x4){0u, 0u, 0u, 0u}; }
    { u32x2* S2 = (u32x2*)(ws + WS_SC);
      for (int i = F.gt; i < 256 * 512; i += F.NT) { const int row = i >> 9, c4 = i & 511; f32x4 v = (f32x4){0.f, 0.f, 0.f, 0.f};
          if (row < 4) v = ((const f32x4*)INP(I_CP))[row * 512 + c4]; else if (row < 132) v = ((const f32x4*)INP(I_CS))[(row - 4) * 512 + c4];
          u32x2 w; w.x = cvt_pk_bf16(fsilu(v[0]), fsilu(v[1])); w.y = cvt_pk_bf16(fsilu(v[2]), fsilu(v[3])); S2[i] = w; } }
    { float* LB = (float*)(ws + WS_LB); const float* lg = INP(I_LBL);
      for (int i = F.gt; i < 1024; i += F.NT) { const float l0 = lg[i], l1 = lg[1024 + i], mx = fmaxf(l0, l1), e0 = expf(l0 - mx), e1 = expf(l1 - mx), s0 = e0 / (e0 + e1), s1 = e1 / (e0 + e1);
          LB[i] = s0 - s0; LB[1024 + i] = (s0 + s1) - s0; } }
    { float* LL = (float*)(ws + WS_LL); const float* lam = INP(I_LAMBDA);
      for (int i = F.gt; i < 2 * DRNN; i += F.NT) LL[i] = -8.0f * log1pf(expf(-lam[i])); }
    { bf16* WG = (bf16*)(ws + WS_WGATE);
      for (int i = F.gt; i < 2 * 20 * 256 * 48; i += F.NT) { const int k8 = i % 48, r = (i / 48) & 255, pn = (i / (48 * 256)) % 20, j = i / (48 * 256 * 20);
          const int ch = 128 * pn + (r & 127), bl = ch / 160, jc = ch % 160; int ks = ((pn * 128) / 160) * 160; ks = ks < 2176 ? ks : 2176;
          const float* W = (r < 128 ? INP(I_WGA) : INP(I_WGX)) + (size_t)(j * 16 + bl) * 160 * 160 + jc; float v[8];
#pragma unroll
          for (int e = 0; e < 8; ++e) { const int ci = ks + k8 * 8 + e; const int cin = ci - bl * 160; v[e] = (cin >= 0 && cin < 160) ? W[(size_t)cin * 160] : 0.f; }
          u32x4 w; w.x = cvt_pk_bf16(v[0], v[1]); w.y = cvt_pk_bf16(v[2], v[3]); w.z = cvt_pk_bf16(v[4], v[5]); w.w = cvt_pk_bf16(v[6], v[7]);
          *(u32x4*)(WG + ((size_t)(j * 20 + pn) * 256 + r) * 2560 + ks + k8 * 8) = w; } }
}


__device__ __forceinline__ void phase_ada_conv(const Frame& F) {
    const int pair = F.bx >> 1, odd = F.bx & 1, nA = odd ? 4 : 5;
    if (F.G == 256) {
        if (F.wave < nA) phase_ada(F, pair * 9 + (odd ? 5 + F.wave : F.wave), 1152);
        else { const int cw = pair * 7 + (odd ? 3 + (F.wave - 4) : (F.wave - 5)); for (int it = cw; it < CONV_PRO; it += 896) conv_ordered(it, F.lane); }
    } else { phase_ada(F, F.gw, F.NGW); for (int it = F.gw; it < CONV_PRO; it += F.NGW) conv_ordered(it, F.lane); }
}

__device__ __forceinline__ float row_ss(const f32x8 (&v)[4]) { float s = 0.f;
#pragma unroll
    for (int jx = 0; jx < 4; ++jx) s += ((v[jx][0] * v[jx][0] + v[jx][1] * v[jx][1]) + (v[jx][2] * v[jx][2] + v[jx][3] * v[jx][3])) + ((v[jx][4] * v[jx][4] + v[jx][5] * v[jx][5]) + (v[jx][6] * v[jx][6] + v[jx][7] * v[jx][7]));
    return 1.0f / sqrtf(wave_sum(s) * (1.0f / D) + EPS); }
__device__ __forceinline__ f32x8 cat8(const f32x4 a, const f32x4 b) { return (f32x8){a[0], a[1], a[2], a[3], b[0], b[1], b[2], b[3]}; }
__device__ __forceinline__ u32x4 pack8(const f32x8 h) { u32x4 o; o.x = cvt_pk_bf16(h[0], h[1]); o.y = cvt_pk_bf16(h[2], h[3]); o.z = cvt_pk_bf16(h[4], h[5]); o.w = cvt_pk_bf16(h[6], h[7]); return o; }
__device__ __forceinline__ void sample_row_fold(h16* X, const float* PART, int row, int nsplit, int lane, f32x8 (&v)[4]) {
    h16x8* xr = (h16x8*)(X + (size_t)row * D) + lane;
#pragma unroll
    for (int jx = 0; jx < 4; ++jx) v[jx] = __builtin_convertvector(xr[64 * jx], f32x8);
    if (nsplit > 0) {
        for (int ks = 0; ks < nsplit; ++ks) { const f32x8* pp = (const f32x8*)(PART + ((size_t)ks * 128 + (row - TP)) * D) + lane;
#pragma unroll
            for (int jx = 0; jx < 4; ++jx) v[jx] += pp[64 * jx]; }
#pragma unroll
        for (int jx = 0; jx < 4; ++jx) xr[64 * jx] = __builtin_convertvector(v[jx], h16x8); }
}
__device__ __forceinline__ void phase_norm(const Frame& F, int l, int which, int nsplit) {
    h16* X = (h16*)(WSP + WS_X); const float* PART = (const float*)(WSP + WS_PART); bf16* H = (bf16*)(WSP + WS_H); const float* MOD = (const float*)(WSP + WS_MOD);
    const float* nw = INP(I_NW) + (size_t)(l * 3 + which) * D; const float* mbase = MOD + (size_t)l * NMODW + (size_t)(3 * which) * D;
    LAS float* T = (LAS float*)F.lds;
    for (int i = F.tid; i < 4 * 512; i += NTHR) { const int b = i >> 9, c4 = (i & 511) * 4; const f32x4 w = *(const f32x4*)(nw + c4), sh = *(const f32x4*)(mbase + (size_t)b * MODLD + c4), sc = *(const f32x4*)(mbase + (size_t)b * MODLD + D + c4);
        *(LAS f32x4*)(T + (b * 2) * 2048 + c4) = w * (sc + 1.0f); *(LAS f32x4*)(T + (b * 2 + 1) * 2048 + c4) = sh; }
    if (F.gw < TS) { const int row = TP + F.gw; f32x8 v[4]; sample_row_fold(X, PART, row, nsplit, F.lane, v); const float rs = row_ss(v);
        const float* mp = mbase + (size_t)(4 + F.gw) * MODLD; u32x4* hp = (u32x4*)(H + (size_t)row * D) + F.lane;
#pragma unroll
        for (int jx = 0; jx < 4; ++jx) { const int c = 8 * (F.lane + 64 * jx); const f32x8 w = cat8(*(const f32x4*)(nw + c), *(const f32x4*)(nw + c + 4)), sh = cat8(*(const f32x4*)(mp + c), *(const f32x4*)(mp + c + 4)), sc = cat8(*(const f32x4*)(mp + D + c), *(const f32x4*)(mp + D + c + 4));
            hp[64 * jx] = pack8((v[jx] * rs) * w * (sc + 1.0f) + sh); } }
    __syncthreads();
    for (int row = F.gw; row < TP; row += 2 * F.NGW) { const int rowb = row + F.NGW; const bool hasb = rowb < TP;
        const h16x8* xa = (const h16x8*)(X + (size_t)row * D) + F.lane; const h16x8* xb = (const h16x8*)(X + (size_t)(hasb ? rowb : row) * D) + F.lane; f32x8 va[4], vb[4];
#pragma unroll
        for (int jx = 0; jx < 4; ++jx) { va[jx] = __builtin_convertvector(xa[64 * jx], f32x8); vb[jx] = __builtin_convertvector(xb[64 * jx], f32x8); }
        const float ra = row_ss(va), rb = row_ss(vb);
        const LAS float* ta = T + ((row >> 11) * 2) * 2048; const LAS float* tb = T + (((hasb ? rowb : row) >> 11) * 2) * 2048;
        u32x4* ha = (u32x4*)(H + (size_t)row * D) + F.lane; u32x4* hb = (u32x4*)(H + (size_t)rowb * D) + F.lane;
#pragma unroll
        for (int jx = 0; jx < 4; ++jx) { const int c = 8 * (F.lane + 64 * jx);
            ha[64 * jx] = pack8((va[jx] * ra) * cat8(*(const LAS f32x4*)(ta + c), *(const LAS f32x4*)(ta + c + 4)) + cat8(*(const LAS f32x4*)(ta + 2048 + c), *(const LAS f32x4*)(ta + 2048 + c + 4)));
            if (hasb) hb[64 * jx] = pack8((vb[jx] * rb) * cat8(*(const LAS f32x4*)(tb + c), *(const LAS f32x4*)(tb + c + 4)) + cat8(*(const LAS f32x4*)(tb + 2048 + c), *(const LAS f32x4*)(tb + 2048 + c + 4))); }
    }
    __syncthreads();
}
__device__ __forceinline__ void phase_final(const Frame& F, int nsplit) {
    h16* X = (h16*)(WSP + WS_X); const float* PART = (const float*)(WSP + WS_PART); const float* fw = INP(I_FNW); float* out = OUTP + O_Y;
    if (F.gw < TS) { const int row = TP + F.gw; f32x8 v[4]; sample_row_fold(X, PART, row, nsplit, F.lane, v); const float rs = row_ss(v); f32x8* op = (f32x8*)(out + (size_t)row * D) + F.lane;
#pragma unroll
        for (int jx = 0; jx < 4; ++jx) { const int c = 8 * (F.lane + 64 * jx); op[64 * jx] = (v[jx] * rs) * cat8(*(const f32x4*)(fw + c), *(const f32x4*)(fw + c + 4)); } }
    for (int row = F.gw; row < TP; row += F.NGW) {
        const h16x8* xr = (const h16x8*)(X + (size_t)row * D) + F.lane; f32x8 v[4];
#pragma unroll
        for (int jx = 0; jx < 4; ++jx) v[jx] = __builtin_convertvector(xr[64 * jx], f32x8);
        const float rs = row_ss(v); f32x8* op = (f32x8*)(out + (size_t)row * D) + F.lane;
#pragma unroll
        for (int jx = 0; jx < 4; ++jx) { const int c = 8 * (F.lane + 64 * jx); op[64 * jx] = (v[jx] * rs) * cat8(*(const f32x4*)(fw + c), *(const f32x4*)(fw + c + 4)); }
    }
}

__device__ __forceinline__ void s5_params(int j, int g, int n, float& ar, float& ai, float (&bbr)[16], float (&bbi)[16]) {
    const float step = expf(INP(I_LSTEP)[j * 64 + g]); const int gi = (j * 64 + g) * 64 + n;
    const float lr = INP(I_LAMRE)[gi], li = INP(I_LAMIM)[gi], mag = expf(lr * step); float sn, cs; sincos_acc(li * step, sn, cs);
    ar = mag * cs; ai = mag * sn;
    const float den = lr * lr + li * li, pr = ar - 1.0f, pim = ai, zr = (pr * lr + pim * li) / den, zi = (pim * lr - pr * li) / den;
    const f32x4* br = (const f32x4*)(INP(I_BRE) + (size_t)gi * 16); const f32x4* bi = (const f32x4*)(INP(I_BIM) + (size_t)gi * 16);
#pragma unroll
    for (int q = 0; q < 4; ++q) { const f32x4 r4 = br[q], i4 = bi[q];
#pragma unroll
        for (int e = 0; e < 4; ++e) { bbr[4 * q + e] = zr * r4[e] - zi * i4[e]; bbi[4 * q + e] = zr * i4[e] + zi * r4[e]; } }
}
__device__ __forceinline__ void s5_load_u(const bf16* Z, int row0, int g, LAS float* ut, int lane) {
    const u32x4* p = (const u32x4*)(Z + (size_t)(row0 + lane) * DIN + g * 16); const u32x4 w0 = p[0], w1 = p[1];
    LAS f32x4* o = (LAS f32x4*)(ut + lane * 16);
    o[0] = (f32x4){bflo(w0.x), bfhi(w0.x), bflo(w0.y), bfhi(w0.y)}; o[1] = (f32x4){bflo(w0.z), bfhi(w0.z), bflo(w0.w), bfhi(w0.w)};
    o[2] = (f32x4){bflo(w1.x), bfhi(w1.x), bflo(w1.y), bfhi(w1.y)}; o[3] = (f32x4){bflo(w1.z), bfhi(w1.z), bflo(w1.w), bfhi(w1.w)};
    asm volatile("s_waitcnt lgkmcnt(0)" ::: "memory");
}
#define S5_STEP(utrow) do { const LAS f32x4* _u = (const LAS f32x4*)(utrow); const f32x4 u0 = _u[0], u1 = _u[1], u2 = _u[2], u3 = _u[3]; float xr = 0.f, xi = 0.f; \
    _Pragma("unroll") for (int e = 0; e < 4; ++e) { xr = fmaf(bbr[e], u0[e], xr); xi = fmaf(bbi[e], u0[e], xi); xr = fmaf(bbr[4 + e], u1[e], xr); xi = fmaf(bbi[4 + e], u1[e], xi); \
        xr = fmaf(bbr[8 + e], u2[e], xr); xi = fmaf(bbi[8 + e], u2[e], xi); xr = fmaf(bbr[12 + e], u3[e], xr); xi = fmaf(bbi[12 + e], u3[e], xi); } \
    const float nr = fmaf(ar, hr, fmaf(-ai, hi, xr)), ni = fmaf(ar, hi, fmaf(ai, hr, xi)); hr = nr; hi = ni; } while (0)

__device__ __forceinline__ void s5_sample(const Frame& F, int j) {
    const bf16* Z = (const bf16*)(WSP + WS_Z); bf16* YA = (bf16*)(WSP + WS_YA);
    LAS float* hb = (LAS float*)(F.lds + F.wave * 4096);
    for (int item = F.vcu; item < 256; item += F.G) { const int g = item >> 2, bq = item & 3, n = F.lane;
        float ar, ai, bbr[16], bbi[16]; s5_params(j, g, n, ar, ai, bbr, bbi);
        for (int i = 0; i < 4; ++i) { const int b = bq * 32 + F.wave * 4 + i, row = TP + b;
            const u32x4* p = (const u32x4*)(Z + (size_t)row * DIN + g * 16); const u32x4 w0 = p[0], w1 = p[1];
            float u[16] = {bflo(w0.x), bfhi(w0.x), bflo(w0.y), bfhi(w0.y), bflo(w0.z), bfhi(w0.z), bflo(w0.w), bfhi(w0.w), bflo(w1.x), bfhi(w1.x), bflo(w1.y), bfhi(w1.y), bflo(w1.z), bfhi(w1.z), bflo(w1.w), bfhi(w1.w)};
            const size_t si = (size_t)((j * 128 + b) * 64 + g) * 64 + n; const float h0r = INP(I_S5RE)[si], h0i = INP(I_S5IM)[si];
            float xr = 0.f, xi = 0.f;
#pragma unroll
            for (int e = 0; e < 16; ++e) { xr = fmaf(bbr[e], u[e], xr); xi = fmaf(bbi[e], u[e], xi); }
            const float hr = ar * h0r - ai * h0i + xr, hi = ar * h0i + ai * h0r + xi;
            OUTP[O_SS5R + si] = hr; OUTP[O_SS5I + si] = hi;
            hb[n] = hr; hb[64 + n] = hi; asm volatile("s_waitcnt lgkmcnt(0)" ::: "memory");
            if (n < 16) { const float* cr = INP(I_CRE) + (size_t)((j * 64 + g) * 16 + n) * 64; const float* ci = INP(I_CIM) + (size_t)((j * 64 + g) * 16 + n) * 64; float y = 0.f;
                for (int q = 0; q < 64; ++q) y += hb[q] * cr[q] - hb[64 + q] * ci[q];
                float uk = 0.f;
#pragma unroll
                for (int e = 0; e < 16; ++e) uk = (n == e) ? u[e] : uk;
                y += INP(I_S5D)[j * 1024 + g * 16 + n] * uk;
                YA[(size_t)row * DA + g * 16 + n] = (bf16)(cvt_pk_bf16(fgelu(y), 0.f) & 0xffffu); }
            asm volatile("s_waitcnt lgkmcnt(0)" ::: "memory");
        }
    }
}
typedef short bf16x4 __attribute__((ext_vector_type(4)));
__device__ __forceinline__ void s5_disc(int j, int g, int n, float& ar, float& ai, float& zr, float& zi) {
    const float step = expf(INP(I_LSTEP)[j * 64 + g]); const int gi = (j * 64 + g) * 64 + n;
    const float lr = INP(I_LAMRE)[gi], li = INP(I_LAMIM)[gi], mag = expf(lr * step); float sn, cs; sincos_acc(li * step, sn, cs);
    ar = mag * cs; ai = mag * sn; const float den = lr * lr + li * li, pr = ar - 1.0f, pim = ai; zr = (pr * lr + pim * li) / den; zi = (pim * lr - pr * li) / den;
}
__device__ __forceinline__ void s5_fused(const Frame& F, int j) {
    unsigned char* ws = WSP; const bf16* Z = (const bf16*)(ws + WS_Z); bf16* YA = (bf16*)(ws + WS_YA);
    LAS float* X2 = (LAS float*)(F.lds + F.wave * 14592);
    LAS unsigned char* Hb = F.lds + F.wave * 14592 + 10240;
    LAS float* EX = (LAS float*)(F.lds + 8 * 14592);
    const int n = F.lane, r = F.lane & 15, kq = F.lane >> 4, c = F.wave;
    for (int item = F.vcu; item < 256; item += F.G) { const int b = item >> 6, g = item & 63, row0 = b * 2048 + c * 256;
        float ar, ai, zr0, zi0; s5_disc(j, g, n, ar, ai, zr0, zi0);
        bf16x4 bre[4], bim[4];
#pragma unroll
        for (int st = 0; st < 4; ++st) { const int ns = st * 16 + r; float a0, a1, zr, zi; s5_disc(j, g, ns, a0, a1, zr, zi); const size_t bo = (size_t)((j * 64 + g) * 64 + ns) * 16 + 4 * kq;
            const f32x4 br = *(const f32x4*)(INP(I_BRE) + bo), bi = *(const f32x4*)(INP(I_BIM) + bo); const f32x4 xr = br * zr - bi * zi, xi = bi * zr + br * zi;
            u32x2 pr; pr.x = cvt_pk_bf16(xr[0], xr[1]); pr.y = cvt_pk_bf16(xr[2], xr[3]); u32x2 pi; pi.x = cvt_pk_bf16(xi[0], xi[1]); pi.y = cvt_pk_bf16(xi[2], xi[3]);
            bre[st] = __builtin_bit_cast(bf16x4, pr); bim[st] = __builtin_bit_cast(bf16x4, pi); }
        u32x2 uf[16];
#pragma unroll
        for (int blk = 0; blk < 16; ++blk) uf[blk] = *(const u32x2*)(Z + (size_t)(row0 + blk * 16 + r) * DIN + g * 16 + 4 * kq);
        const f32x4 zero4 = (f32x4){0.f, 0.f, 0.f, 0.f};
#define S5_XBLK(blk) do { const bf16x4 ua = __builtin_bit_cast(bf16x4, uf[blk]); \
            _Pragma("unroll") for (int st = 0; st < 4; ++st) { const f32x4 xr4 = __builtin_amdgcn_mfma_f32_16x16x16bf16_1k(ua, bre[st], zero4, 0, 0, 0), xi4 = __builtin_amdgcn_mfma_f32_16x16x16bf16_1k(ua, bim[st], zero4, 0, 0, 0); \
                *(LAS f32x4*)(X2 + (st * 16 + r) * 20 + 4 * kq) = xr4; *(LAS f32x4*)(X2 + (64 + st * 16 + r) * 20 + 4 * kq) = xi4; } \
            asm volatile("s_waitcnt lgkmcnt(0)" ::: "memory"); } while (0)
        float hr = 0.f, hi = 0.f;
#pragma unroll
        for (int blk = 0; blk < 16; ++blk) { S5_XBLK(blk);
#pragma unroll
            for (int q = 0; q < 4; ++q) { const f32x4 xr4 = *(const LAS f32x4*)(X2 + n * 20 + 4 * q), xi4 = *(const LAS f32x4*)(X2 + (64 + n) * 20 + 4 * q);
#pragma unroll
                for (int e = 0; e < 4; ++e) { const float nr = fmaf(ar, hr, fmaf(-ai, hi, xr4[e])), ni = fmaf(ar, hi, fmaf(ai, hr, xi4[e])); hr = nr; hi = ni; } }
            asm volatile("s_waitcnt lgkmcnt(0)" ::: "memory"); }
        __syncthreads();
        EX[c * 128 + n] = hr; EX[c * 128 + 64 + n] = hi;
        __syncthreads();
        float pr = ar, pi = ai;
#pragma unroll
        for (int q = 0; q < 8; ++q) { const float t0 = pr * pr - pi * pi, t1 = 2.0f * pr * pi; pr = t0; pi = t1; }
        hr = 0.f; hi = 0.f;
        for (int cc = 0; cc < c; ++cc) { const float er = EX[cc * 128 + n], ei = EX[cc * 128 + 64 + n]; const float nr = pr * hr - pi * hi + er, ni = pr * hi + pi * hr + ei; hr = nr; hi = ni; }
        pg8::bf16x8 ctf[4];
#pragma unroll
        for (int ks = 0; ks < 4; ++ks) { const int np0 = ks * 32 + kq * 8; const float* src = (np0 < 64 ? INP(I_CRE) : INP(I_CIM)) + (size_t)((j * 64 + g) * 16 + r) * 64 + (np0 & 63); const float sg = np0 < 64 ? 1.0f : -1.0f;
            const f32x4 c0 = *(const f32x4*)src * sg, c1 = *(const f32x4*)(src + 4) * sg; u32x4 o; o.x = cvt_pk_bf16(c0[0], c0[1]); o.y = cvt_pk_bf16(c0[2], c0[3]); o.z = cvt_pk_bf16(c1[0], c1[1]); o.w = cvt_pk_bf16(c1[2], c1[3]); ctf[ks] = __builtin_bit_cast(pg8::bf16x8, o); }
        const f32x4 dsk = *(const f32x4*)(INP(I_S5D) + j * 1024 + g * 16 + 4 * kq);
#pragma unroll
        for (int blk = 0; blk < 16; ++blk) { S5_XBLK(blk);
#pragma unroll
            for (int q = 0; q < 4; ++q) { const f32x4 xr4 = *(const LAS f32x4*)(X2 + n * 20 + 4 * q), xi4 = *(const LAS f32x4*)(X2 + (64 + n) * 20 + 4 * q);
#pragma unroll
                for (int e = 0; e < 4; ++e) { const float nr = fmaf(ar, hr, fmaf(-ai, hi, xr4[e])), ni = fmaf(ar, hi, fmaf(ai, hr, xi4[e])); hr = nr; hi = ni;
                    const unsigned hw = cvt_pk_bf16(hr, hi); *(LAS unsigned short*)(Hb + (4 * q + e) * 272 + n * 2) = (unsigned short)(hw & 0xffffu); *(LAS unsigned short*)(Hb + (4 * q + e) * 272 + (64 + n) * 2) = (unsigned short)(hw >> 16); } }
            asm volatile("s_waitcnt lgkmcnt(0)" ::: "memory");
            f32x4 y = zero4;
#pragma unroll
            for (int ks = 0; ks < 4; ++ks) y = __builtin_amdgcn_mfma_f32_16x16x32_bf16(ctf[ks], *(const LAS pg8::bf16x8*)(Hb + r * 272 + ks * 64 + kq * 16), y, 0, 0, 0);
            y += dsk * (f32x4){bflo(uf[blk].x), bfhi(uf[blk].x), bflo(uf[blk].y), bfhi(uf[blk].y)};
            u32x2 wv; wv.x = cvt_pk_bf16(fgelu(y[0]), fgelu(y[1])); wv.y = cvt_pk_bf16(fgelu(y[2]), fgelu(y[3]));
            *(u32x2*)(YA + (size_t)(row0 + blk * 16 + r) * DA + g * 16 + 4 * kq) = wv;
            asm volatile("s_waitcnt lgkmcnt(0)" ::: "memory"); }
#undef S5_XBLK
        if (c == 7) { const size_t si = (size_t)((j * 4 + b) * 64 + g) * 64 + n; OUTP[O_PS5R + si] = hr; OUTP[O_PS5I + si] = hi; }
    }
    __syncthreads();
}

__device__ __forceinline__ pg8::bf16x8 lds_frag(const LAS unsigned char* base, int row, int stride, int kbyte) { return *(const LAS pg8::bf16x8*)(base + row * stride + kbyte); }
__device__ __forceinline__ void hgrn_h1(const Frame& F, int j) {
    unsigned char* ws = WSP; const bf16* Z = (const bf16*)(ws + WS_Z); float* OB = (float*)(ws + WS_OB); const float* LB = (const float*)(ws + WS_LB) + j * 1024;
    float* TT = (float*)(ws + WS_HT); bf16* QG = (bf16*)(ws + WS_QG); float* HD = (float*)(ws + WS_HD);
    LAS unsigned char* QT = F.lds; LAS unsigned char* KT = QT + 17408; LAS unsigned char* KHT = KT + 17408; LAS unsigned char* VT = KHT + 18432; LAS unsigned char* PT = VT + 18432; LAS float* SEG = (LAS float*)(PT + 9216);
    const int col = F.tid & 127, seg = F.tid >> 7, t0 = seg * 16, r = F.lane & 15, kq = F.lane >> 4, w = F.wave;
    for (int item = F.vcu; item < 1024; item += F.G) { const int b = item >> 8, c = (item >> 3) & 31, h = item & 7, row0 = b * 2048 + c * 64;
        const bf16* zq = Z + (size_t)(row0 + t0) * DIN + 1024 + h * 128 + col; const float lb = LB[h * 128 + col];
        float q[16], kk[16], g[16]; unsigned short vr[16];
#pragma unroll
        for (int i = 0; i < 16; ++i) { const float qv = __uint_as_float((unsigned)zq[(size_t)i * DIN] << 16), fz = __uint_as_float((unsigned)zq[(size_t)i * DIN + 1024] << 16); vr[i] = zq[(size_t)i * DIN + 2048];
            const float s = fsigmoid(fz), f = lb + (1.0f - lb) * s; q[i] = qv; kk[i] = (1.0f - lb) * (1.0f - s); g[i] = __logf(f); }
#pragma unroll
        for (int i = 1; i < 16; ++i) g[i] += g[i - 1];
        __syncthreads();
        SEG[seg * 128 + col] = g[15];
        __syncthreads();
        const float s0 = SEG[col], s1 = SEG[128 + col], s2 = SEG[256 + col], s3 = SEG[384 + col];
        const float pre = seg == 0 ? 0.f : seg == 1 ? s0 : seg == 2 ? s0 + s1 : s0 + s1 + s2, Gm = s0 + s1, Gl = (s0 + s1) + (s2 + s3);
        unsigned khb[8];
#pragma unroll
        for (int i = 0; i < 16; ++i) { const float G = pre + g[i]; const float qt = q[i] * __expf(G - Gm), kt = kk[i] * __expf(Gm - G), kh = kk[i] * __expf(Gl - G), qg = q[i] * __expf(G);
            const unsigned p0 = cvt_pk_bf16(qt, kt), p1 = cvt_pk_bf16(kh, qg);
            *(LAS unsigned short*)(QT + (t0 + i) * 272 + col * 2) = (unsigned short)(p0 & 0xffffu); *(LAS unsigned short*)(KT + (t0 + i) * 272 + col * 2) = (unsigned short)(p0 >> 16);
            QG[((size_t)item * 64 + t0 + i) * 128 + col] = (bf16)(p1 >> 16);
            if (i & 1) khb[i >> 1] |= (p1 & 0xffffu) << 16; else khb[i >> 1] = p1 & 0xffffu; }
        *(LAS u32x4*)(KHT + col * 144 + t0 * 2) = (u32x4){khb[0], khb[1], khb[2], khb[3]}; *(LAS u32x4*)(KHT + col * 144 + t0 * 2 + 16) = (u32x4){khb[4], khb[5], khb[6], khb[7]};
        *(LAS u32x4*)(VT + col * 144 + t0 * 2) = (u32x4){(unsigned)vr[0] | ((unsigned)vr[1] << 16), (unsigned)vr[2] | ((unsigned)vr[3] << 16), (unsigned)vr[4] | ((unsigned)vr[5] << 16), (unsigned)vr[6] | ((unsigned)vr[7] << 16)};
        *(LAS u32x4*)(VT + col * 144 + t0 * 2 + 16) = (u32x4){(unsigned)vr[8] | ((unsigned)vr[9] << 16), (unsigned)vr[10] | ((unsigned)vr[11] << 16), (unsigned)vr[12] | ((unsigned)vr[13] << 16), (unsigned)vr[14] | ((unsigned)vr[15] << 16)};
        if (seg == 0) HD[(size_t)item * 128 + col] = __expf(Gl);
        __syncthreads();
        { const int tt = w & 3;
#pragma unroll
          for (int u = 0; u < 2; ++u) { const int st = 2 * (w >> 2) + u; f32x4 acc = (f32x4){0.f, 0.f, 0.f, 0.f};
              if (st <= tt) {
#pragma unroll
                  for (int ks = 0; ks < 4; ++ks) acc = __builtin_amdgcn_mfma_f32_16x16x32_bf16(lds_frag(KT, st * 16 + r, 272, ks * 64 + kq * 16), lds_frag(QT, tt * 16 + r, 272, ks * 64 + kq * 16), acc, 0, 0, 0); }
              const int t = tt * 16 + r, sb = st * 16 + 4 * kq;
              u32x2 pw; pw.x = cvt_pk_bf16(sb <= t ? acc[0] : 0.f, sb + 1 <= t ? acc[1] : 0.f); pw.y = cvt_pk_bf16(sb + 2 <= t ? acc[2] : 0.f, sb + 3 <= t ? acc[3] : 0.f);
              *(LAS u32x2*)(PT + t * 144 + sb * 2) = pw; } }
        __syncthreads();
        { const int tt = w & 3; const pg8::bf16x8 p0 = lds_frag(PT, tt * 16 + r, 144, kq * 16), p1 = lds_frag(PT, tt * 16 + r, 144, 64 + kq * 16);
#pragma unroll
          for (int u = 0; u < 4; ++u) { const int vt = 4 * (w >> 2) + u; f32x4 acc = (f32x4){0.f, 0.f, 0.f, 0.f};
              acc = __builtin_amdgcn_mfma_f32_16x16x32_bf16(lds_frag(VT, vt * 16 + r, 144, kq * 16), p0, acc, 0, 0, 0); acc = __builtin_amdgcn_mfma_f32_16x16x32_bf16(lds_frag(VT, vt * 16 + r, 144, 64 + kq * 16), p1, acc, 0, 0, 0);
              *(f32x4*)(OB + (size_t)(row0 + tt * 16 + r) * 1024 + h * 128 + vt * 16 + 4 * kq) = acc; } }
        { const int vt = w; const pg8::bf16x8 v0 = lds_frag(VT, vt * 16 + r, 144, kq * 16), v1 = lds_frag(VT, vt * 16 + r, 144, 64 + kq * 16);
#pragma unroll
          for (int kt = 0; kt < 8; ++kt) { f32x4 acc = (f32x4){0.f, 0.f, 0.f, 0.f};
              acc = __builtin_amdgcn_mfma_f32_16x16x32_bf16(lds_frag(KHT, kt * 16 + r, 144, kq * 16), v0, acc, 0, 0, 0); acc = __builtin_amdgcn_mfma_f32_16x16x32_bf16(lds_frag(KHT, kt * 16 + r, 144, 64 + kq * 16), v1, acc, 0, 0, 0);
              *(f32x4*)(TT + ((size_t)item * 128 + vt * 16 + r) * 128 + kt * 16 + 4 * kq) = acc; } }
    }
    __syncthreads();
}
__device__ __forceinline__ void hgrn_h2(const Frame& F, int j) {
    unsigned char* ws = WSP; const float* TT = (const float*)(ws + WS_HT); const float* HD = (const float*)(ws + WS_HD); bf16* HS = (bf16*)(ws + WS_HS);
    for (int e = F.gt; e < 32 * 128 * 32; e += F.NT) { const int bh = e >> 12, v = (e >> 5) & 127, k4 = (e & 31) * 4, b = bh >> 3, h = bh & 7;
        f32x4 S = (f32x4){0.f, 0.f, 0.f, 0.f};
#pragma unroll 4
        for (int c = 0; c < 32; ++c) { const size_t item = (size_t)(b * 32 + c) * 8 + h; const size_t o = (item * 128 + v) * 128 + k4;
            u32x2 sw; sw.x = cvt_pk_bf16(S[0], S[1]); sw.y = cvt_pk_bf16(S[2], S[3]); *(u32x2*)(HS + o) = sw;
            const f32x4 T = *(const f32x4*)(TT + o), Dv = *(const f32x4*)(HD + item * 128 + k4); S = Dv * S + T; }
        float* op = OUTP + O_PHG + ((size_t)((j * 4 + b) * 8 + h) * 128 + k4) * 128 + v;
#pragma unroll
        for (int q = 0; q < 4; ++q) op[(size_t)q * 128] = S[q]; }
}
__device__ __forceinline__ void hgrn_h3(const Frame& F, int j) {
    unsigned char* ws = WSP; const bf16* Z = (const bf16*)(ws + WS_Z); bf16* MIX = (bf16*)(ws + WS_MIX); const float* OB = (const float*)(ws + WS_OB); const bf16* QG = (const bf16*)(ws + WS_QG); const bf16* HS = (const bf16*)(ws + WS_HS);
    const int half = F.wave >> 2, tt = F.wave & 3, r = F.lane & 15, kq = F.lane >> 4;
    for (int it2 = F.vcu * 2; it2 < 1024; it2 += 2 * F.G) { const int item = it2 + half, b = item >> 8, c = (item >> 3) & 31, h = item & 7, row = b * 2048 + c * 64 + tt * 16 + r;
        pg8::bf16x8 qf[4];
#pragma unroll
        for (int ks = 0; ks < 4; ++ks) qf[ks] = *(const pg8::bf16x8*)(QG + ((size_t)item * 64 + tt * 16 + r) * 128 + ks * 32 + kq * 8);
        f32x4 o[8]; float ss = 0.f;
#pragma unroll
        for (int vt = 0; vt < 8; ++vt) { f32x4 acc = *(const f32x4*)(OB + (size_t)row * 1024 + h * 128 + vt * 16 + 4 * kq);
#pragma unroll
            for (int ks = 0; ks < 4; ++ks) acc = __builtin_amdgcn_mfma_f32_16x16x32_bf16(*(const pg8::bf16x8*)(HS + ((size_t)item * 128 + vt * 16 + r) * 128 + ks * 32 + kq * 8), qf[ks], acc, 0, 0, 0);
            o[vt] = acc; ss += (acc[0] * acc[0] + acc[1] * acc[1]) + (acc[2] * acc[2] + acc[3] * acc[3]); }
        ss += swz_xor16(ss); ss += __int_as_float(__builtin_amdgcn_ds_bpermute((F.lane ^ 32) << 2, __float_as_int(ss)));
        const float rs = 1.0f / sqrtf(ss * (1.0f / 128.0f) + EPS);
#pragma unroll
        for (int vt = 0; vt < 8; ++vt) { const int cv = h * 128 + vt * 16 + 4 * kq; const u32x2 gv = *(const u32x2*)(Z + (size_t)row * DIN + 4096 + cv); const f32x4 gw = *(const f32x4*)(INP(I_HGNW) + j * 128 + vt * 16 + 4 * kq);
            u32x2 y; y.x = cvt_pk_bf16(o[vt][0] * rs * gw[0] * fsilu(bflo(gv.x)), o[vt][1] * rs * gw[1] * fsilu(bfhi(gv.x))); y.y = cvt_pk_bf16(o[vt][2] * rs * gw[2] * fsilu(bflo(gv.y)), o[vt][3] * rs * gw[3] * fsilu(bfhi(gv.y)));
            *(u32x2*)(MIX + (size_t)row * D + 1024 + cv) = y; }
    }
}
__device__ __forceinline__ void hgrn_sample(const Frame& F, int j) {
    const bf16* Z = (const bf16*)(WSP + WS_Z); bf16* MIX = (bf16*)(WSP + WS_MIX); const float* LB = (const float*)(WSP + WS_LB) + j * 1024;
    LAS float* fb = (LAS float*)F.lds; LAS float* kb = fb + 128; LAS float* qb = kb + 128; LAS float* vb = qb + 128; LAS float* gb = vb + 128; LAS float* red = gb + 128; LAS float* POL = red + 128;
    const int tid = F.tid, v4 = (tid & 31) * 4, kq = tid >> 5;
    for (int item = F.vcu; item < 1024; item += F.G) { const int b = item >> 3, h = item & 7, row = TP + b;
        __syncthreads();
        if (tid < 128) { const bf16* zr = Z + (size_t)row * DIN + h * 128 + tid; const float lb = LB[h * 128 + tid];
            const float q = __uint_as_float((unsigned)zr[1024] << 16), fz = __uint_as_float((unsigned)zr[2048] << 16), iv = __uint_as_float((unsigned)zr[3072] << 16), g = __uint_as_float((unsigned)zr[4096] << 16);
            const float s = fsigmoid(fz); fb[tid] = lb + (1.0f - lb) * s; kb[tid] = (1.0f - lb) * (1.0f - s); qb[tid] = q; vb[tid] = iv; gb[tid] = g; }
        __syncthreads();
        const f32x4 vv = *(const LAS f32x4*)(vb + v4); f32x4 po = (f32x4){0.f, 0.f, 0.f, 0.f};
        const size_t sbase = (size_t)((j * 128 + b) * 8 + h) * 128 * 128;
#pragma unroll
        for (int i = 0; i < 8; ++i) { const int k = kq + 16 * i; const f32x4 s0 = *(const f32x4*)(INP(I_HG) + sbase + (size_t)k * 128 + v4);
            const f32x4 s1 = s0 * fb[k] + vv * kb[k]; *(f32x4*)(OUTP + O_SHG + sbase + (size_t)k * 128 + v4) = s1; po += s1 * qb[k]; }
        *(LAS f32x4*)(POL + kq * 128 + v4) = po;
        __syncthreads();
        float o = 0.f;
        if (tid < 128) {
#pragma unroll
            for (int i = 0; i < 16; ++i) o += POL[i * 128 + tid];
            const float ss = wave_sum(o * o); if (F.lane == 0) red[F.wave] = ss; }
        __syncthreads();
        if (tid < 128) { const float rs = 1.0f / sqrtf((red[0] + red[1]) * (1.0f / 128.0f) + EPS); const float y = o * rs * INP(I_HGNW)[j * 128 + tid] * fsilu(gb[tid]);
            MIX[(size_t)row * D + 1024 + h * 128 + tid] = (bf16)(cvt_pk_bf16(y, 0.f) & 0xffffu); }
    }
    __syncthreads();
}
__device__ __forceinline__ void unpack8(const u32x4 w, float (&x)[8]) { x[0] = bflo(w.x); x[1] = bfhi(w.x); x[2] = bflo(w.y); x[3] = bfhi(w.y); x[4] = bflo(w.z); x[5] = bfhi(w.z); x[6] = bflo(w.w); x[7] = bfhi(w.w); }
__device__ __forceinline__ void lru_conv(const Frame& F, int j) {
    const bf16* XR = (const bf16*)(WSP + WS_XR); bf16* XCB = (bf16*)(WSP + WS_XCB);
    const float* cw = INP(I_CONVW) + (size_t)j * 4 * DRNN; const float* cb = INP(I_CONVB) + (size_t)j * DRNN;
    for (int i = F.gt; i < TT * 320; i += F.NT) { const int row = i / 320, c8 = (i % 320) * 8;
        float x0[8], x1[8], x2[8], x3[8]; unpack8(*(const u32x4*)(XR + (size_t)row * DRNN + c8), x3);
        if (row < TP) { const int t = row & 2047, b = row >> 11; const u32x4 z = (u32x4){0u, 0u, 0u, 0u};
            unpack8(t >= 1 ? *(const u32x4*)(XR + (size_t)(row - 1) * DRNN + c8) : z, x2); unpack8(t >= 2 ? *(const u32x4*)(XR + (size_t)(row - 2) * DRNN + c8) : z, x1); unpack8(t >= 3 ? *(const u32x4*)(XR + (size_t)(row - 3) * DRNN + c8) : z, x0);
            if (t >= 2045) { float* op = OUTP + O_PCONV + (size_t)((j * 4 + b) * 3 + (t - 2045)) * DRNN + c8; *(f32x4*)op = (f32x4){x3[0], x3[1], x3[2], x3[3]}; *(f32x4*)(op + 4) = (f32x4){x3[4], x3[5], x3[6], x3[7]}; }
        } else { const int b = row - TP; const float* cbuf = INP(I_CONV) + (size_t)(j * 128 + b) * 3 * DRNN + c8; float* ob = OUTP + O_SCONV + (size_t)(j * 128 + b) * 3 * DRNN + c8;
#pragma unroll
            for (int e = 0; e < 8; ++e) { x0[e] = cbuf[e]; x1[e] = cbuf[DRNN + e]; x2[e] = cbuf[2 * DRNN + e]; ob[e] = x1[e]; ob[DRNN + e] = x2[e]; ob[2 * DRNN + e] = x3[e]; } }
        float xc[8];
#pragma unroll
        for (int e = 0; e < 8; ++e) xc[e] = cb[c8 + e] + x0[e] * cw[c8 + e] + x1[e] * cw[DRNN + c8 + e] + x2[e] * cw[2 * DRNN + c8 + e] + x3[e] * cw[3 * DRNN + c8 + e];
        u32x4 w; w.x = cvt_pk_bf16(xc[0], xc[1]); w.y = cvt_pk_bf16(xc[2], xc[3]); w.z = cvt_pk_bf16(xc[4], xc[5]); w.w = cvt_pk_bf16(xc[6], xc[7]); *(u32x4*)(XCB + (size_t)row * DRNN + c8) = w; }
}
__device__ __forceinline__ void lru_scan1(const Frame& F) {
    const unsigned* AB = (const unsigned*)(WSP + WS_AA); float* P = (float*)(WSP + WS_LRUP);
    for (int i = F.gt; i < 4 * 16 * 1280; i += F.NT) { const int cp = i % 1280, bc = i / 1280; const size_t base = (size_t)(bc * 128) * DRNN + 2 * cp;
        f32x2 L = (f32x2){0.f, 0.f}, Bv = (f32x2){0.f, 0.f};
#pragma unroll 8
        for (int t = 0; t < 128; ++t) { const u32x2 w = *(const u32x2*)(AB + base + (size_t)t * DRNN); const f32x2 la = (f32x2){bflo(w.x), bflo(w.y)}, bv = (f32x2){bfhi(w.x), bfhi(w.y)};
            L += la; Bv = (f32x2){__expf(la[0]), __expf(la[1])} * Bv + bv; }
        *(f32x4*)(P + (size_t)i * 4) = (f32x4){__expf(L[0]), __expf(L[1]), Bv[0], Bv[1]}; }
}
__device__ __forceinline__ void lru_scan2(const Frame& F, int j) {
    const unsigned* AB = (const unsigned*)(WSP + WS_AA); const float* P = (const float*)(WSP + WS_LRUP);
    const bf16* GB = (const bf16*)(WSP + WS_Z); bf16* MIX = (bf16*)(WSP + WS_MIX);
    for (int i = F.gt; i < 4 * 16 * 1280; i += F.NT) { const int cp = i % 1280, bc = i / 1280, c = bc & 15, b = bc >> 4; const size_t base = (size_t)(bc * 128) * DRNN + 2 * cp;
        f32x2 h = (f32x2){0.f, 0.f};
        for (int cc = 0; cc < c; ++cc) { const f32x4 pv = *(const f32x4*)(P + (size_t)((b * 16 + cc) * 1280 + cp) * 4); h = (f32x2){pv[0], pv[1]} * h + (f32x2){pv[2], pv[3]}; }
#pragma unroll 8
        for (int t = 0; t < 128; ++t) { const size_t o = base + (size_t)t * DRNN; const u32x2 w = *(const u32x2*)(AB + o); const unsigned gw = *(const unsigned*)(GB + o);
            h = (f32x2){__expf(bflo(w.x)), __expf(bflo(w.y))} * h + (f32x2){bfhi(w.x), bfhi(w.y)}; *(unsigned*)(MIX + o) = cvt_pk_bf16(bflo(gw) * h[0], bfhi(gw) * h[1]); }
        if (c == 15) *(f32x2*)(OUTP + O_PLRU + (size_t)(j * 4 + b) * DRNN + 2 * cp) = h; }
    for (int i = F.gt; i < TS * 1280; i += F.NT) { const int cp = i % 1280, b = i / 1280; const size_t o = (size_t)(TP + b) * DRNN + 2 * cp;
        const u32x2 w = *(const u32x2*)(AB + o); const f32x2 h0 = *(const f32x2*)(INP(I_LRU) + (size_t)(j * 128 + b) * DRNN + 2 * cp); const unsigned gw = *(const unsigned*)(GB + o);
        const f32x2 h = (f32x2){__expf(bflo(w.x)), __expf(bflo(w.y))} * h0 + (f32x2){bfhi(w.x), bfhi(w.y)}; *(f32x2*)(OUTP + O_SLRU + (size_t)(j * 128 + b) * DRNN + 2 * cp) = h; *(unsigned*)(MIX + o) = cvt_pk_bf16(bflo(gw) * h[0], bfhi(gw) * h[1]); }
}

#define GEMM_CALL(EpiT, OrdT, E, Aptr, Bptr, LDA, LDB, KK, NM, NN) do { pg8::Gemm g_{(const pg8::bf16_t*)(Aptr), (const pg8::bf16_t*)(Bptr), (LDA), (LDB), (KK)}; OrdT S_; S_.init((NM), (NN), F.G, F.bx); \
    pg8::gemm_phase<EpiT, OrdT, true, true>(F.lds, g_, S_, (E), F.tid); } while (0)
#define GEMM_RES(MODP, SCALE, Aptr, Bptr, LDK, NSPL) do { { EpiRes E{(h16*)(ws + WS_X), (MODP), (SCALE)}; GEMM_CALL(EpiRes, pg8::StaticOrder, E, Aptr, Bptr, LDK, LDK, LDK, 32, 8); } \
    { EpiResPart E2{(float*)(ws + WS_PART), (MODP), (SCALE)}; pg8::Gemm g_{(const pg8::bf16_t*)(Aptr), (const pg8::bf16_t*)(Bptr), (LDK), (LDK), (LDK) / (NSPL)}; pg8::SplitKOrder S_; S_.init(32, 8, (NSPL), (LDK) / (NSPL), F.G, F.bx); \
      pg8::gemm_phase<EpiResPart, pg8::SplitKOrder, true, true>(F.lds, g_, S_, E2, F.tid); } } while (0)
__device__ __forceinline__ Frame make_frame(LAS unsigned char* lds, int wid) {
    Frame F; F.lds = lds; int ln = (int)__builtin_amdgcn_mbcnt_hi(~0u, __builtin_amdgcn_mbcnt_lo(~0u, 0u)); asm volatile("" : "+v"(ln)); int bx = blockIdx.x; asm volatile("" : "+s"(bx));
    F.lane = ln; F.wave = wid; F.tid = wid * 64 + ln; F.G = gridDim.x; F.bx = bx;
    F.vcu = (F.G % 8 == 0) ? (bx % 8) * (F.G / 8) + bx / 8 : bx;
    F.gw = F.vcu * NWAVES + F.wave; F.NGW = F.G * NWAVES; F.gt = F.vcu * NTHR + F.tid; F.NT = F.G * NTHR; return F;
}
__global__ void __launch_bounds__(NTHR, 2) fwd_kernel(Args a_unused) {
    extern __shared__ __attribute__((aligned(16))) unsigned char lds_raw[];
    LAS unsigned char* const lds = (LAS unsigned char*)lds_raw;
    volatile LAS unsigned* MISC = (volatile LAS unsigned*)(lds + MISC_OFF);
    for (int u = threadIdx.x; u < (LDS_BYTES - 131072) / 4; u += NTHR) ((LAS unsigned*)(lds + 131072))[u] = 0u;
    __syncthreads();
    int wid0 = __builtin_amdgcn_readfirstlane((int)threadIdx.x >> 6); asm volatile("" : "+s"(wid0)); const int wid = wid0;
    XcdBarrier bar = xcd_barrier_post((unsigned*)(WSP + WS_CTL) + CW_BAR, MISC + 8, wid);
    const int lo = (int)(unsigned)kargs()[N_IN + 2], hi = (int)(unsigned)(kargs()[N_IN + 2] >> 32); int ph = 0;
#define PH_BEGIN if (ph >= lo && ph < hi) { const Frame F = make_frame(lds, wid); unsigned char* const ws = WSP;
#define PH_END } if (ph >= lo && ph + 1 < hi) xcd_barrier(bar); ++ph;

    PH_BEGIN phase_prologue(F); PH_END
    PH_BEGIN phase_ada_conv(F); PH_END

    for (int l = 0; l < 4; ++l) {
        const int j = l >> 1;
#define MODL ((const float*)(ws + WS_MOD) + (size_t)l * NMODW)
        for (int s = 0; s < 2; ++s) {
            if (s == 1) {
                PH_BEGIN phase_norm(F, l, 1, 7); PH_END
                if ((l & 1) == 0) {
                    PH_BEGIN { EpiBf16 E{(bf16*)(ws + WS_Z), DIN}; GEMM_CALL(EpiBf16, pg8::StaticOrder, E, ws + WS_H, ws + WS_WINAB + (size_t)j * 5120 * 2048 * 2, 2048, 2048, 2048, NPAN, 20); conv_slot(F, l, 1, 148); } PH_END
                    PH_BEGIN s5_sample(F, j); __syncthreads(); hgrn_h1(F, j); hgrn_sample(F, j); PH_END
                    PH_BEGIN hgrn_h2(F, j); s5_fused(F, j); PH_END
                    PH_BEGIN hgrn_h3(F, j); PH_END
                    PH_BEGIN { EpiGlu E{(bf16*)(ws + WS_MIX), (const bf16*)(ws + WS_YA), INP(I_BGLU) + j * 1024}; GEMM_CALL(EpiGlu, pg8::StaticOrder, E, ws + WS_YA, ws + WS_WGLU + (size_t)j * 1024 * 1024 * 2, 1024, 1024, 1024, NPAN, 4); } PH_END
                    PH_BEGIN GEMM_RES(MODL + 5 * D, 1.0f, ws + WS_MIX, ws + WS_WOUTAB + (size_t)j * 2048 * 2048 * 2, 2048, 4); PH_END
                } else {
                    PH_BEGIN { EpiInC E{(bf16*)(ws + WS_Z), (bf16*)(ws + WS_XR)}; GEMM_CALL(EpiInC, pg8::StaticOrder, E, ws + WS_H, ws + WS_WINC + (size_t)j * 5120 * 2048 * 2, 2048, 2048, 2048, NPAN, 20); conv_slot(F, l, 1, 148); } PH_END
                    PH_BEGIN lru_conv(F, j); PH_END
                    PH_BEGIN { EpiGate E{(unsigned*)(ws + WS_AA), (const bf16*)(ws + WS_XCB), INP(I_BGA) + j * DRNN, INP(I_BGX) + j * DRNN, (const float*)(ws + WS_LL) + j * DRNN};
                               GEMM_CALL(EpiGate, pg8::GateOrder, E, ws + WS_XCB, ws + WS_WGATE + (size_t)j * 5120 * 2560 * 2, 2560, 2560, 384, NPAN, 20); } PH_END
                    PH_BEGIN lru_scan1(F); PH_END
                    PH_BEGIN lru_scan2(F, j); PH_END
                    PH_BEGIN GEMM_RES(MODL + 5 * D, 1.0f, ws + WS_MIX, ws + WS_WOUTC + (size_t)j * 2048 * 2560 * 2, 2560, 5); PH_END
                }
            }
            PH_BEGIN phase_norm(F, l, s == 0 ? 0 : 2, s == 0 ? (l == 0 ? 0 : 7) : ((l & 1) ? 5 : 4)); PH_END
            PH_BEGIN { EpiGU E{(bf16*)(ws + WS_HID)}; GEMM_CALL(EpiGU, pg8::StaticOrder, E, ws + WS_H, ws + WS_WGU + (size_t)(l * 2 + s) * 10752 * 2048 * 2, 2048, 2048, 2048, NPAN, 42); conv_slot(F, l, s == 0 ? 0 : 2, 106); } PH_END
            PH_BEGIN GEMM_RES(MODL + (s == 0 ? 2 : 8) * D, 0.5f, ws + WS_HID, ws + WS_WD + (size_t)(l * 2 + s) * 2048 * 5376 * 2, 5376, 7); PH_END
        }
    }
    PH_BEGIN phase_final(F, 7); PH_END
}
constexpr int N_PHASES = 2 + 4 * (3 + 1 + 3) + 2 * 6 + 2 * 6 + 1;

extern "C" void kernel_launch(void* const* d_in, const int* in_sizes, int n_in, void* d_out, int out_size, void* d_ws, size_t ws_size, hipStream_t stream) {
    static int grid = 0;
    if (grid == 0) {
        if (n_in != N_IN || (size_t)out_size != O_END || ws_size < WS_END) { fprintf(stderr, "kernel_launch: unexpected shapes: n_in %d out %d ws %zu (need %zu)\n", n_in, out_size, ws_size, (size_t)WS_END); grid = -1; return; }
        int dev = 0, cus = 0, per_cu = 0;
        if (hipGetDevice(&dev) != hipSuccess || hipDeviceGetAttribute(&cus, hipDeviceAttributeMultiprocessorCount, dev) != hipSuccess) { grid = -1; return; }
        if (hipFuncSetAttribute((const void*)fwd_kernel, hipFuncAttributeMaxDynamicSharedMemorySize, LDS_BYTES) != hipSuccess) { fprintf(stderr, "kernel_launch: hipFuncSetAttribute failed\n"); grid = -1; return; }
        if (hipOccupancyMaxActiveBlocksPerMultiprocessor(&per_cu, (const void*)fwd_kernel, NTHR, LDS_BYTES) != hipSuccess || per_cu < 1) { fprintf(stderr, "kernel_launch: occupancy query says %d\n", per_cu); }
        (void)hipGetLastError();
        grid = cus;
    }
    if (grid < 0) return;
    (void)hipMemsetAsync((char*)d_ws + WS_CTL, 0, CTL_BYTES, stream);
    Args a{};
    for (int i = 0; i < N_IN; ++i) a.in[i] = (const float*)d_in[i];
    a.out = (float*)d_out; a.ws = (unsigned char*)d_ws;
#ifndef MK_PER_PHASE
    a.lo = 0; a.hi = N_PHASES;
    hipLaunchKernelGGL(fwd_kernel, dim3(grid), dim3(NTHR), LDS_BYTES, stream, a);
#else
    for (int p = 0; p < N_PHASES; ++p) { a.lo = p; a.hi = p + 1; hipLaunchKernelGGL(fwd_kernel, dim3(grid), dim3(NTHR), LDS_BYTES, stream, a); }
#endif
}
```
